# Optimizing an MI355X kernel written in HIP

```python
import jax, jax.numpy as jnp
from jax import lax
import numpy as np

D_MODEL = 2048
BATCH = 4
SEQ = 2048
DEPTH = 1

PLE_DIM = 256
POOL_WINDOWS = (2, 4, 8, 16)
N_POOL_GROUPS = 4
POOL_WIDTH = D_MODEL // 2
POOL_GROUP = POOL_WIDTH // N_POOL_GROUPS
CONV_WIDTH = D_MODEL // 2
CONV_K = 3
N_IN = POOL_WIDTH + 3 * CONV_WIDTH + 2 * D_MODEL
N_EXPERTS = 32
TOP_K = 4
D_FF = D_MODEL
SWIGLU_LIMIT = 7.0
SWIGLU_ALPHA = 1.702
MOE_BLOCK = 128
LN_EPS = 1e-5
DEEPNORM_ALPHA = (2.0 * DEPTH) ** 0.25
DEEPNORM_BETA = (8.0 * DEPTH) ** -0.25

kernel_name = "hybrid_pool_shortconv_moe_deepnorm"


def layer_norm(x, g, b):
    xf = x.astype(jnp.float32)
    mu = jnp.mean(xf, axis=-1, keepdims=True)
    var = jnp.mean(jnp.square(xf - mu), axis=-1, keepdims=True)
    y = (xf - mu) * lax.rsqrt(var + LN_EPS)
    return (y * g.astype(jnp.float32) + b.astype(jnp.float32)).astype(x.dtype)


def causal_multiscale_pool(u):
    B, T, _ = u.shape
    ug = u.reshape(B, T, N_POOL_GROUPS, POOL_GROUP).astype(jnp.float32)
    cs = jnp.cumsum(ug, axis=1)
    t1 = jnp.arange(1, T + 1, dtype=jnp.float32)
    outs = []
    for g, w in enumerate(POOL_WINDOWS):
        cp = jnp.pad(cs[:, :, g], ((0, 0), (w, 0), (0, 0)))
        win_sum = cp[:, w:] - cp[:, :T]
        cnt = jnp.minimum(t1, float(w))[None, :, None]
        outs.append(win_sum / cnt)
    pooled = jnp.stack(outs, axis=2)
    return (pooled - ug).astype(u.dtype)


def causal_short_conv(s, conv_w):
    T = s.shape[1]
    sp = jnp.pad(s, ((0, 0), (CONV_K - 1, 0), (0, 0)))
    acc = sp[:, 0:T] * conv_w[0]
    for k in range(1, CONV_K):
        acc = acc + sp[:, k:k + T] * conv_w[k]
    return acc


def token_mixer(x, w_in, w_pool, pool_scale, conv_w, w_br_a, w_br_b, w_o):
    B, T, _ = x.shape
    proj = x @ w_in
    o0 = POOL_WIDTH
    o1 = o0 + CONV_WIDTH
    o2 = o1 + CONV_WIDTH
    o3 = o2 + CONV_WIDTH
    o4 = o3 + D_MODEL
    u_a = proj[..., :o0]
    c_b = proj[..., o0:o1]
    c_c = proj[..., o1:o2]
    c_v = proj[..., o2:o3]
    g_a = proj[..., o3:o4]
    g_b = proj[..., o4:]
    pooled = causal_multiscale_pool(u_a)
    a = jnp.einsum('btgc,gcd->btgd', pooled, w_pool).reshape(B, T, POOL_WIDTH) * pool_scale
    b = c_b * causal_short_conv(c_c * c_v, conv_w)
    m = jax.nn.sigmoid(g_a) * (a @ w_br_a) + jax.nn.sigmoid(g_b) * (b @ w_br_b)
    return m @ w_o


def moe(h, w_router, b_router, w_gu, b_gu, w_down, b_down):
    B, T, D = h.shape
    N = B * T
    NK = N * TOP_K
    hf = h.reshape(N, D)
    logits = (hf @ w_router + b_router).astype(jnp.float32)
    top_v, top_e = lax.top_k(logits, TOP_K)
    gates = jax.nn.softmax(top_v, axis=-1).astype(h.dtype)
    e_flat = top_e.reshape(NK).astype(jnp.int32)
    g_flat = gates.reshape(NK)
    tok_flat = jnp.arange(NK, dtype=jnp.int32) // TOP_K
    onehot = jax.nn.one_hot(e_flat, N_EXPERTS, dtype=jnp.int32)
    rank = jnp.sum(jnp.cumsum(onehot, axis=0) * onehot, axis=-1) - 1
    counts = jnp.sum(onehot, axis=0)
    padded = (counts + MOE_BLOCK - 1) // MOE_BLOCK * MOE_BLOCK
    pad_ends = jnp.cumsum(padded)
    pad_starts = pad_ends - padded
    dest = pad_starts[e_flat] + rank
    n_blocks = (NK + N_EXPERTS * (MOE_BLOCK - 1) + MOE_BLOCK - 1) // MOE_BLOCK
    cap = n_blocks * MOE_BLOCK
    slot_tok = jnp.full((cap,), N, jnp.int32).at[dest].set(tok_flat)
    slot_gate = jnp.zeros((cap,), h.dtype).at[dest].set(g_flat)
    block_starts = jnp.arange(n_blocks, dtype=jnp.int32) * MOE_BLOCK
    block_e = jnp.minimum(jnp.searchsorted(pad_ends, block_starts, side='right'), N_EXPERTS - 1)
    h_pad = jnp.concatenate([hf, jnp.zeros((1, D), h.dtype)], axis=0)
    xs = h_pad[slot_tok].reshape(n_blocks, MOE_BLOCK, D)

    def expert_block(args):
        xb, e = args
        gu = xb @ w_gu[e] + b_gu[e]
        gate = jnp.minimum(gu[:, :D_FF], SWIGLU_LIMIT)
        up = jnp.clip(gu[:, D_FF:], -SWIGLU_LIMIT, SWIGLU_LIMIT)
        act = (up + 1.0) * (gate * jax.nn.sigmoid(SWIGLU_ALPHA * gate))
        return act @ w_down[e] + b_down[e]

    ys = lax.map(expert_block, (xs, block_e)).reshape(cap, D)
    out = jax.ops.segment_sum(ys * slot_gate[:, None], slot_tok, num_segments=N + 1)[:N]
    return out.reshape(B, T, D)


def setup_inputs(seed: int = 0) -> dict:
    key = jax.random.key(seed)
    ks = jax.random.split(key, 26)
    f32 = jnp.float32
    L = DEPTH

    def nrm(k, shape, scale):
        return jax.random.normal(k, shape, f32) * scale

    return {
        "x": nrm(ks[0], (BATCH, SEQ, D_MODEL), 1.0),
        "p": nrm(ks[1], (DEPTH, BATCH, SEQ, PLE_DIM), 1.0),
        "w_in": nrm(ks[2], (L, D_MODEL, N_IN), D_MODEL ** -0.5),
        "w_pool": nrm(ks[3], (L, N_POOL_GROUPS, POOL_GROUP, POOL_GROUP), POOL_GROUP ** -0.5),
        "pool_scale": 1.0 + nrm(ks[4], (L, POOL_WIDTH), 0.02),
        "conv_w": nrm(ks[5], (L, CONV_K, CONV_WIDTH), CONV_K ** -0.5),
        "w_br_a": nrm(ks[6], (L, POOL_WIDTH, D_MODEL), POOL_WIDTH ** -0.5 * DEEPNORM_BETA),
        "w_br_b": nrm(ks[7], (L, CONV_WIDTH, D_MODEL), CONV_WIDTH ** -0.5 * DEEPNORM_BETA),
        "w_o": nrm(ks[8], (L, D_MODEL, D_MODEL), D_MODEL ** -0.5 * DEEPNORM_BETA),
        "ln1_g": 1.0 + nrm(ks[9], (L, D_MODEL), 0.02),
        "ln1_b": nrm(ks[10], (L, D_MODEL), 0.02),
        "w_router": nrm(ks[11], (L, D_MODEL, N_EXPERTS), D_MODEL ** -0.5),
        "b_router": nrm(ks[12], (L, N_EXPERTS), 0.01),
        "w_gu": nrm(ks[13], (L, N_EXPERTS, D_MODEL, 2 * D_FF), D_MODEL ** -0.5),
        "b_gu": nrm(ks[14], (L, N_EXPERTS, 2 * D_FF), 0.01),
        "w_down": nrm(ks[15], (L, N_EXPERTS, D_FF, D_MODEL), D_FF ** -0.5 * DEEPNORM_BETA),
        "b_down": nrm(ks[16], (L, N_EXPERTS, D_MODEL), 0.01),
        "ln2_g": 1.0 + nrm(ks[17], (L, D_MODEL), 0.02),
        "ln2_b": nrm(ks[18], (L, D_MODEL), 0.02),
        "w_pg": nrm(ks[19], (L, D_MODEL, D_MODEL), D_MODEL ** -0.5),
        "b_pg": nrm(ks[20], (L, D_MODEL), 0.01),
        "w_ple": nrm(ks[21], (L, PLE_DIM, D_MODEL), PLE_DIM ** -0.5 * DEEPNORM_BETA),
        "ln3_g": 1.0 + nrm(ks[22], (L, D_MODEL), 0.02),
        "ln3_b": nrm(ks[23], (L, D_MODEL), 0.02),
    }


def reference(x, p, w_in, w_pool, pool_scale, conv_w, w_br_a, w_br_b, w_o, ln1_g, ln1_b,
              w_router, b_router, w_gu, b_gu, w_down, b_down, ln2_g, ln2_b,
              w_pg, b_pg, w_ple, ln3_g, ln3_b):
    for i in range(DEPTH):
        mix = token_mixer(x, w_in[i], w_pool[i], pool_scale[i], conv_w[i],
                          w_br_a[i], w_br_b[i], w_o[i])
        x1 = layer_norm(DEEPNORM_ALPHA * x + mix, ln1_g[i], ln1_b[i])
        ffn = moe(x1, w_router[i], b_router[i], w_gu[i], b_gu[i], w_down[i], b_down[i])
        h2 = layer_norm(DEEPNORM_ALPHA * x1 + ffn, ln2_g[i], ln2_b[i])
        ple = jax.nn.sigmoid(h2 @ w_pg[i] + b_pg[i]) * (p[i] @ w_ple[i])
        x = layer_norm(DEEPNORM_ALPHA * h2 + ple, ln3_g[i], ln3_b[i])
    return x
```

```cpp
#include <hip/hip_runtime.h>
#include <cstdio>
#include <cstdint>
namespace nv {
constexpr int NTOK = 8192, DM = 2048, NIN = 8192, NE = 32, TOPK = 4, PLE = 256, SEQL = 2048;
constexpr float ALPHA = 1.189207115002721f;
constexpr float LN_EPS = 1e-5f;

enum { M_PROJ = 0, M_PLE, M_POOL, M_BRA, M_BRB, M_WO, M_GU, M_DOWN, M_PG };

struct P {
    const float* A; int lda;
    const float* B; int ldb;
    float* C; int ldc;
    int M, N, K;
    const float* aux0; const float* aux1; const float* aux2; const float* aux3;
    const int* cnt; const int* off; const int* list;
};

__device__ __forceinline__ float sigm(float v) { return 1.0f / (1.0f + __expf(-v)); }

template <int MODE>
__global__ void __launch_bounds__(256) gemm(P p) {
    __shared__ float As[16][132];
    __shared__ float Bs[16][128];
    const int tid = threadIdx.x, tx = tid & 15, ty = tid >> 4;
    const int e = blockIdx.z;
    int M = p.M; const float* A = p.A; const float* B = p.B; const int* list = nullptr; int rowoff = 0;
    if (MODE == M_GU || MODE == M_DOWN) { M = p.cnt[e]; rowoff = p.off[e]; list = p.list + e * NTOK; }
    if (MODE == M_GU) B += (size_t)e * DM * (2 * DM);
    if (MODE == M_DOWN) B += (size_t)e * DM * DM;
    if (MODE == M_POOL) { A += e * 256; B += (size_t)e * 256 * 256; }
    const int m0 = blockIdx.y * 128; if (m0 >= M) return;
    const int n0 = (MODE == M_GU) ? blockIdx.x * 64 : blockIdx.x * 128;
    float acc[8][8];
#pragma unroll
    for (int i = 0; i < 8; ++i)
#pragma unroll
        for (int j = 0; j < 8; ++j) acc[i][j] = 0.f;
    const float* arow[8]; bool aval[8];
#pragma unroll
    for (int i = 0; i < 8; ++i) {
        const int idx = tid + 256 * i, r = idx >> 4;
        const int m = m0 + r; aval[i] = m < M;
        if (MODE == M_GU) { const int tok = aval[i] ? (list[m] >> 2) : 0; arow[i] = A + (size_t)tok * p.lda; }
        else if (MODE == M_DOWN) arow[i] = A + (size_t)(rowoff + (aval[i] ? m : 0)) * p.lda;
        else arow[i] = A + (size_t)(aval[i] ? m : 0) * p.lda;
    }
    for (int k0 = 0; k0 < p.K; k0 += 16) {
#pragma unroll
        for (int i = 0; i < 8; ++i) { const int idx = tid + 256 * i, r = idx >> 4, c = idx & 15; As[c][r] = aval[i] ? arow[i][k0 + c] : 0.f; }
#pragma unroll
        for (int i = 0; i < 8; ++i) { const int idx = tid + 256 * i, r = idx >> 7, c = idx & 127;
            int col = n0 + c; if (MODE == M_GU) col = (c < 64) ? (n0 + c) : (DM + n0 + (c - 64));
            Bs[r][c] = B[(size_t)(k0 + r) * p.ldb + col]; }
        __syncthreads();
#pragma unroll
        for (int kk = 0; kk < 16; ++kk) {
            float a[8], b[8];
#pragma unroll
            for (int i = 0; i < 8; ++i) a[i] = As[kk][ty + 16 * i];
#pragma unroll
            for (int j = 0; j < 8; ++j) b[j] = Bs[kk][tx + 16 * j];
#pragma unroll
            for (int i = 0; i < 8; ++i)
#pragma unroll
                for (int j = 0; j < 8; ++j) acc[i][j] = fmaf(a[i], b[j], acc[i][j]);
        }
        __syncthreads();
    }
#pragma unroll
    for (int i = 0; i < 8; ++i) {
        const int m = m0 + ty + 16 * i; if (m >= M) continue;
        if (MODE == M_GU) {
#pragma unroll
            for (int j = 0; j < 4; ++j) { const int n = n0 + tx + 16 * j;
                const float g = fminf(acc[i][j] + p.aux0[(size_t)e * 2 * DM + n], 7.0f);
                const float u = fminf(fmaxf(acc[i][j + 4] + p.aux0[(size_t)e * 2 * DM + DM + n], -7.0f), 7.0f);
                p.C[(size_t)(rowoff + m) * p.ldc + n] = (u + 1.0f) * (g * sigm(1.702f * g)); }
            continue;
        }
#pragma unroll
        for (int j = 0; j < 8; ++j) { const int n = n0 + tx + 16 * j; const float v = acc[i][j];
            if (MODE == M_PROJ) p.C[(size_t)m * p.ldc + n] = (n >= 4096) ? sigm(v) : v;
            if (MODE == M_PLE) p.C[(size_t)m * p.ldc + n] = v;
            if (MODE == M_POOL) p.C[(size_t)m * p.ldc + e * 256 + n] = v * p.aux0[e * 256 + n];
            if (MODE == M_BRA) p.C[(size_t)m * p.ldc + n] = p.aux0[(size_t)m * NIN + 4096 + n] * v;
            if (MODE == M_BRB) p.C[(size_t)m * p.ldc + n] += p.aux0[(size_t)m * NIN + 6144 + n] * v;
            if (MODE == M_WO) p.C[(size_t)m * p.ldc + n] = ALPHA * p.aux0[(size_t)m * DM + n] + v;
            if (MODE == M_DOWN) p.C[(size_t)list[m] * p.ldc + n] = v + p.aux0[(size_t)e * DM + n];
            if (MODE == M_PG) p.C[(size_t)m * p.ldc + n] = ALPHA * p.aux0[(size_t)m * DM + n] + sigm(v + p.aux1[n]) * p.aux2[(size_t)m * DM + n];
        }
    }
}

__global__ void __launch_bounds__(256) poolconv(const float* proj, const float* conv_w, float* pooled, float* bconv) {
    const int idx = blockIdx.x * 256 + threadIdx.x; const int t = idx >> 10, c = idx & 1023, tl = t & (SEQL - 1);
    const int g = c >> 8, w = 2 << g; const int n = (tl + 1 < w) ? tl + 1 : w;
    float s = 0.f; for (int j = 0; j < n; ++j) s += proj[(size_t)(t - j) * NIN + c];
    pooled[(size_t)t * 1024 + c] = s / (float)n - proj[(size_t)t * NIN + c];
    float acc = 0.f;
#pragma unroll
    for (int j = 0; j < 3; ++j) { const int d = 2 - j; if (tl - d >= 0) acc += conv_w[j * 1024 + c] * proj[(size_t)(t - d) * NIN + 2048 + c] * proj[(size_t)(t - d) * NIN + 3072 + c]; }
    bconv[(size_t)t * 1024 + c] = proj[(size_t)t * NIN + 1024 + c] * acc;
}

__device__ __forceinline__ float block_sum(float v, float* red) {
#pragma unroll
    for (int o = 32; o >= 1; o >>= 1) v += __shfl_xor(v, o);
    __syncthreads(); if ((threadIdx.x & 63) == 0) red[threadIdx.x >> 6] = v; __syncthreads();
    return red[0] + red[1] + red[2] + red[3];
}
template <int MODE  >
__global__ void __launch_bounds__(256) lnrow(const float* src, const float* g, const float* b, float* dst,
                                             const float* w_router, const float* b_router, int* cnt, int* list, int* tok_e, float* tok_gate,
                                             const float* Y) {
    __shared__ float xs[DM]; __shared__ float red[4]; __shared__ float part[8][32]; __shared__ float lg[32];
    const int t = blockIdx.x, tid = threadIdx.x;
    float v[8];
#pragma unroll
    for (int j = 0; j < 8; ++j) { const int c = tid + 256 * j; float x = src[(size_t)t * DM + c];
        if (MODE == 2) { x *= ALPHA;
#pragma unroll
            for (int k = 0; k < 4; ++k) x += tok_gate[t * 4 + k] * Y[(size_t)(t * 4 + k) * DM + c]; }
        v[j] = x; }
    float s = 0.f;
#pragma unroll
    for (int j = 0; j < 8; ++j) s += v[j];
    const float mean = block_sum(s, red) * (1.0f / DM);
    float q = 0.f;
#pragma unroll
    for (int j = 0; j < 8; ++j) { const float d = v[j] - mean; q += d * d; }
    const float var = block_sum(q, red) * (1.0f / DM);
    const float rstd = rsqrtf(var + LN_EPS);
#pragma unroll
    for (int j = 0; j < 8; ++j) { const int c = tid + 256 * j; const float y = (v[j] - mean) * rstd * g[c] + b[c]; dst[(size_t)t * DM + c] = y; if (MODE == 1) xs[c] = y; }
    if (MODE == 1) {
        __syncthreads();
        const int e = tid & 31, pt = tid >> 5; float a = 0.f;
        for (int k = pt * 256; k < pt * 256 + 256; ++k) a = fmaf(xs[k], w_router[k * NE + e], a);
        part[pt][e] = a; __syncthreads();
        if (tid < 32) { float l = b_router[tid]; for (int q2 = 0; q2 < 8; ++q2) l += part[q2][tid]; lg[tid] = l; }
        __syncthreads();
        if (tid == 0) {
            float tv[4]; int te[4]; unsigned used = 0;
#pragma unroll
            for (int k = 0; k < 4; ++k) { float best = -3.0e38f; int bi = 0; for (int i = 0; i < 32; ++i) if (!((used >> i) & 1u) && lg[i] > best) { best = lg[i]; bi = i; } used |= 1u << bi; tv[k] = best; te[k] = bi; }
            float ex[4], sum = 0.f;
#pragma unroll
            for (int k = 0; k < 4; ++k) { ex[k] = __expf(tv[k] - tv[0]); sum += ex[k]; }
#pragma unroll
            for (int k = 0; k < 4; ++k) { tok_e[t * 4 + k] = te[k]; tok_gate[t * 4 + k] = ex[k] / sum; const int r = atomicAdd(&cnt[te[k]], 1); list[te[k] * NTOK + r] = t * 4 + k; }
        }
    }
}
__global__ void offsets(const int* cnt, int* off) { if (threadIdx.x == 0) { int s = 0; for (int e = 0; e < NE; ++e) { off[e] = s; s += cnt[e]; } } }

struct Bufs { float *proj, *ple, *pooled, *bconv, *a, *m, *pre1, *x1, *act, *Y, *h2, *pre3; int *cnt, *off, *list, *tok_e; float* tok_gate; };
constexpr size_t bytes_needed() { return (size_t)NTOK * NIN * 4 + 5ull * NTOK * DM * 4   + 3ull * NTOK * 1024 * 4   + 2ull * NTOK * 4 * DM * 4   + (size_t)NTOK * DM * 4   + (1u << 22); }
inline Bufs carve(char* base) {
    Bufs b; size_t o = 0; auto take = [&](size_t n) { char* r = base + o; o += (n + 255) & ~(size_t)255; return r; };
    b.cnt = (int*)take(256); b.off = (int*)take(256); b.list = (int*)take((size_t)NE * NTOK * 4); b.tok_e = (int*)take((size_t)NTOK * 4 * 4); b.tok_gate = (float*)take((size_t)NTOK * 4 * 4);
    b.proj = (float*)take((size_t)NTOK * NIN * 4); b.ple = (float*)take((size_t)NTOK * DM * 4);
    b.pooled = (float*)take((size_t)NTOK * 1024 * 4); b.bconv = (float*)take((size_t)NTOK * 1024 * 4); b.a = (float*)take((size_t)NTOK * 1024 * 4);
    b.m = (float*)take((size_t)NTOK * DM * 4); b.pre1 = (float*)take((size_t)NTOK * DM * 4); b.x1 = (float*)take((size_t)NTOK * DM * 4);
    b.act = (float*)take((size_t)NTOK * 4 * DM * 4); b.Y = (float*)take((size_t)NTOK * 4 * DM * 4); b.h2 = (float*)take((size_t)NTOK * DM * 4); b.pre3 = (float*)take((size_t)NTOK * DM * 4);
    return b;
}
inline void forward(void* const* d_in, float* out, const Bufs& b, hipStream_t st) {
    const float* x = (const float*)d_in[0]; const float* pin = (const float*)d_in[1]; const float* w_in = (const float*)d_in[2]; const float* w_pool = (const float*)d_in[3];
    const float* pool_scale = (const float*)d_in[4]; const float* conv_w = (const float*)d_in[5]; const float* w_br_a = (const float*)d_in[6]; const float* w_br_b = (const float*)d_in[7];
    const float* w_o = (const float*)d_in[8]; const float* ln1_g = (const float*)d_in[9]; const float* ln1_b = (const float*)d_in[10]; const float* w_router = (const float*)d_in[11];
    const float* b_router = (const float*)d_in[12]; const float* w_gu = (const float*)d_in[13]; const float* b_gu = (const float*)d_in[14]; const float* w_down = (const float*)d_in[15];
    const float* b_down = (const float*)d_in[16]; const float* ln2_g = (const float*)d_in[17]; const float* ln2_b = (const float*)d_in[18]; const float* w_pg = (const float*)d_in[19];
    const float* b_pg = (const float*)d_in[20]; const float* w_ple = (const float*)d_in[21]; const float* ln3_g = (const float*)d_in[22]; const float* ln3_b = (const float*)d_in[23];
    hipMemsetAsync(b.cnt, 0, 256, st);
    { P p{}; p.A = x; p.lda = DM; p.B = w_in; p.ldb = NIN; p.C = b.proj; p.ldc = NIN; p.M = NTOK; p.N = NIN; p.K = DM; gemm<M_PROJ><<<dim3(NIN / 128, NTOK / 128, 1), 256, 0, st>>>(p); }
    { P p{}; p.A = pin; p.lda = PLE; p.B = w_ple; p.ldb = DM; p.C = b.ple; p.ldc = DM; p.M = NTOK; p.N = DM; p.K = PLE; gemm<M_PLE><<<dim3(DM / 128, NTOK / 128, 1), 256, 0, st>>>(p); }
    poolconv<<<NTOK * 1024 / 256, 256, 0, st>>>(b.proj, conv_w, b.pooled, b.bconv);
    { P p{}; p.A = b.pooled; p.lda = 1024; p.B = w_pool; p.ldb = 256; p.C = b.a; p.ldc = 1024; p.M = NTOK; p.N = 256; p.K = 256; p.aux0 = pool_scale; gemm<M_POOL><<<dim3(2, NTOK / 128, 4), 256, 0, st>>>(p); }
    { P p{}; p.A = b.a; p.lda = 1024; p.B = w_br_a; p.ldb = DM; p.C = b.m; p.ldc = DM; p.M = NTOK; p.N = DM; p.K = 1024; p.aux0 = b.proj; gemm<M_BRA><<<dim3(DM / 128, NTOK / 128, 1), 256, 0, st>>>(p); }
    { P p{}; p.A = b.bconv; p.lda = 1024; p.B = w_br_b; p.ldb = DM; p.C = b.m; p.ldc = DM; p.M = NTOK; p.N = DM; p.K = 1024; p.aux0 = b.proj; gemm<M_BRB><<<dim3(DM / 128, NTOK / 128, 1), 256, 0, st>>>(p); }
    { P p{}; p.A = b.m; p.lda = DM; p.B = w_o; p.ldb = DM; p.C = b.pre1; p.ldc = DM; p.M = NTOK; p.N = DM; p.K = DM; p.aux0 = x; gemm<M_WO><<<dim3(DM / 128, NTOK / 128, 1), 256, 0, st>>>(p); }
    lnrow<1><<<NTOK, 256, 0, st>>>(b.pre1, ln1_g, ln1_b, b.x1, w_router, b_router, b.cnt, b.list, b.tok_e, b.tok_gate, nullptr);
    offsets<<<1, 64, 0, st>>>(b.cnt, b.off);
    { P p{}; p.A = b.x1; p.lda = DM; p.B = w_gu; p.ldb = 2 * DM; p.C = b.act; p.ldc = DM; p.M = NTOK; p.N = DM; p.K = DM; p.aux0 = b_gu; p.cnt = b.cnt; p.off = b.off; p.list = b.list; gemm<M_GU><<<dim3(DM / 64, NTOK / 128, NE), 256, 0, st>>>(p); }
    { P p{}; p.A = b.act; p.lda = DM; p.B = w_down; p.ldb = DM; p.C = b.Y; p.ldc = DM; p.M = NTOK; p.N = DM; p.K = DM; p.aux0 = b_down; p.cnt = b.cnt; p.off = b.off; p.list = b.list; gemm<M_DOWN><<<dim3(DM / 128, NTOK / 128, NE), 256, 0, st>>>(p); }
    lnrow<2><<<NTOK, 256, 0, st>>>(b.x1, ln2_g, ln2_b, b.h2, nullptr, nullptr, nullptr, nullptr, nullptr, b.tok_gate, b.Y);
    { P p{}; p.A = b.h2; p.lda = DM; p.B = w_pg; p.ldb = DM; p.C = b.pre3; p.ldc = DM; p.M = NTOK; p.N = DM; p.K = DM; p.aux0 = b.h2; p.aux1 = b_pg; p.aux2 = b.ple; gemm<M_PG><<<dim3(DM / 128, NTOK / 128, 1), 256, 0, st>>>(p); }
    lnrow<0><<<NTOK, 256, 0, st>>>(b.pre3, ln3_g, ln3_b, out, nullptr, nullptr, nullptr, nullptr, nullptr, nullptr, nullptr);
}
}
extern "C" void kernel_launch(void* const* d_in, const int* in_sizes, int n_in, void* d_out, int out_size, void* d_ws, size_t ws_size, hipStream_t stream) {
    if (n_in != 24 || out_size != nv::NTOK * nv::DM || ws_size < nv::bytes_needed()) { fprintf(stderr, "kernel_launch: unexpected shapes / workspace (n_in %d out %d ws %zu)\n", n_in, out_size, ws_size); return; }
    nv::Bufs b = nv::carve((char*)d_ws);
    nv::forward(d_in, (float*)d_out, b, stream);
}
```

```cpp
#include <hip/hip_runtime.h>
#include <cstdio>
#include <cstdint>
namespace fp {
#define LAS __attribute__((address_space(3)))
#define GAS __attribute__((address_space(1)))
typedef unsigned short bf16_t;
typedef short bf16x8 __attribute__((ext_vector_type(8)));
typedef float f32x4 __attribute__((ext_vector_type(4)));
typedef float f32x2 __attribute__((ext_vector_type(2)));
typedef unsigned u32x4 __attribute__((ext_vector_type(4)));
typedef unsigned u32x2 __attribute__((ext_vector_type(2)));
typedef GAS unsigned gu32;

constexpr int NTOK = 8192, DM = 2048, NIN = 8192, NE = 32, SEQL = 2048, PLE = 256, LCAP = 8192;
constexpr float ALPHA = 1.189207115002721f, LN_EPS = 1e-5f;
constexpr int NWAVES = 8;
constexpr int BM = 256, BK = 64, HALF = 128, HTB = HALF * BK * 2, NXCD = 8, WGM = 8;

constexpr size_t MiB = 1u << 20;
constexpr size_t WS_CTL = 0, CTL_ZERO_BYTES = 1 * MiB;
constexpr size_t WS_LIST = 1 * MiB, WS_TOK = 2 * MiB, WS_WPOOL = 3 * MiB, WS_WPLE = 4 * MiB, WS_PB = 5 * MiB, WS_WBRA = 9 * MiB, WS_WBRB = 13 * MiB, WS_WO = 17 * MiB, WS_WPG = 25 * MiB,
                 WS_WIN = 33 * MiB, WS_XB = 65 * MiB, WS_PLEB = 97 * MiB, WS_POOLED = 129 * MiB, WS_BCONV = 145 * MiB, WS_ABUF = 161 * MiB, WS_MB = 177 * MiB, WS_X1B = 209 * MiB,
                 WS_H2B = 241 * MiB, WS_M1 = 273 * MiB, WS_PRE1 = 337 * MiB, WS_X1 = 401 * MiB, WS_H2 = 465 * MiB, WS_PROJ = 529 * MiB, WS_Y = 657 * MiB, WS_ACT = 785 * MiB,
                 WS_WDN = 945 * MiB, WS_WGU = 1201 * MiB, WS_END = 1713 * MiB;
constexpr size_t WS_WRT = WS_TOK + 512 * 1024;
constexpr int CW_TMO = 0, CW_BAR = 4096, CW_CNT = 8192;

constexpr int RING_BYTES = 131072, LDSCTL_OFF = RING_BYTES, LDS_BYTES = 147456;
constexpr int L_CNT = 0, L_UB7 = 256, L_UB8 = 512, L_ROFF = 768, L_BARST = 1024;

__device__ __forceinline__ int lds_byte(int r, int c) { const int st = (r >> 4) * 2 + (c >> 5), rr = r & 15, cc = c & 31, ob = rr * 64 + cc * 2; return st * 1024 + (ob ^ (((ob >> 9) & 1) << 5)); }
__device__ __forceinline__ void stage_rc(int b, int& R, int& C) { const int st = b / 1024, sb = b % 1024, swz = sb ^ (((sb >> 9) & 1) << 5); R = (st >> 1) * 16 + swz / 64; C = (st & 1) * 32 + (swz % 64) / 2; }
__device__ __forceinline__ int perm32(int rho) { const int n = rho >> 4, i = rho & 15; return 8 * (i >> 2) + 4 * n + (i & 3); }
__device__ __forceinline__ unsigned cvt_pk_bf16(float lo, float hi) { unsigned r; asm volatile("v_cvt_pk_bf16_f32 %0, %1, %2" : "=v"(r) : "v"(lo), "v"(hi)); return r; }
__device__ __forceinline__ float bf_lo(unsigned w) { return __uint_as_float(w << 16); }
__device__ __forceinline__ float bf_hi(unsigned w) { return __uint_as_float(w & 0xffff0000u); }
__device__ __forceinline__ float sigm(float v) { return __builtin_amdgcn_rcpf(1.0f + __expf(-v)); }
__device__ __forceinline__ f32x4 sigm4(f32x4 v) { return (f32x4){sigm(v[0]), sigm(v[1]), sigm(v[2]), sigm(v[3])}; }

#define XB_TMO      128
#define XB_XCNT(j)  (256  + 64 * (j))
#define XB_XSUB(j)  (1280 + 64 * (j))
#define XB_XGEN(j)  (2304 + 64 * (j))
#define XB_TOP      3328
#define XB_TOPGEN   3392
#define XCD_BAR_WORDS 3456
#define XB_SPIN_CAP (1u << 18)
__device__ __forceinline__ unsigned xb_ld(unsigned* p)              { return __hip_atomic_load(p, __ATOMIC_RELAXED, __HIP_MEMORY_SCOPE_AGENT); }
__device__ __forceinline__ unsigned xb_add(unsigned* p, unsigned v) { return __hip_atomic_fetch_add(p, v, __ATOMIC_RELAXED, __HIP_MEMORY_SCOPE_AGENT); }
__device__ __forceinline__ unsigned xb_xcc_id() { return (unsigned)__builtin_amdgcn_s_getreg((3 << 11) | 20) & 0xFu; }
#define XB_SPIN(cond, bar) do { unsigned _sp = 0; while (cond) { __builtin_amdgcn_s_sleep(1); \
    if ((++_sp & 255u) == 0u) { if (xb_ld(&(bar)[XB_TMO])) break; if (_sp > XB_SPIN_CAP) { atomicAdd(&(bar)[XB_TMO], 1u); break; } } } } while (0)
struct XcdBarrier { unsigned* bar; unsigned x; volatile LAS unsigned* st; };
__device__ __forceinline__ XcdBarrier xcd_barrier_post(unsigned* bar, volatile LAS unsigned* st) {
    XcdBarrier b; b.bar = bar; b.x = xb_xcc_id(); b.st = st;
    if (threadIdx.x == 0) (void)xb_add(&bar[XB_XCNT(b.x)], 1u);
    return b;
}
__device__ __forceinline__ void xcd_barrier_complete(unsigned* bar, unsigned x, unsigned& nloc, unsigned& nx) {
    const unsigned G = gridDim.x * gridDim.y * gridDim.z;
    unsigned sum, cnt, mine, sp = 0u;
    for (;;) {
        sum = 0u; cnt = 0u; mine = 0u;
#pragma unroll
        for (unsigned j = 0; j < 16; ++j) { const unsigned c = xb_ld(&bar[XB_XCNT(j)]); sum += c; cnt += (c > 0u) ? 1u : 0u; mine = (j == x) ? c : mine; }
        if (sum == G) break;
        __builtin_amdgcn_s_sleep(1);
        if ((++sp & 255u) == 0u) { if (xb_ld(&bar[XB_TMO])) break; if (sp > XB_SPIN_CAP) { atomicAdd(&bar[XB_TMO], 1u); break; } }
    }
    nloc = mine > 0u ? mine : 1u; nx = cnt > 0u ? cnt : 1u;
}
__device__ __forceinline__ void xcd_barrier(const XcdBarrier& b) {
    asm volatile("s_waitcnt vmcnt(0)" ::: "memory");
    __syncthreads();
    if (threadIdx.x == 0) {
        unsigned* bar = b.bar;
        __builtin_amdgcn_s_waitcnt(0);
        unsigned nloc = b.st[0], nx = b.st[1];
        if (nloc == 0u) { xcd_barrier_complete(bar, b.x, nloc, nx); b.st[0] = nloc; b.st[1] = nx; }
        const unsigned old = xb_add(&bar[XB_XSUB(b.x)], 1u);
        const unsigned gen = old / nloc;
        if (old + 1u == (gen + 1u) * nloc) {
            __builtin_amdgcn_fence(__ATOMIC_RELEASE, "agent");
            asm volatile("s_waitcnt vmcnt(0)" ::: "memory");
            const unsigned og = xb_add(&bar[XB_TOP], 1u);
            const unsigned tg = og / nx;
            if (og + 1u == (tg + 1u) * nx) xb_add(&bar[XB_TOPGEN], 1u);
            else XB_SPIN(xb_ld(&bar[XB_TOPGEN]) == tg, bar);
            __builtin_amdgcn_fence(__ATOMIC_ACQUIRE, "agent");
            xb_add(&bar[XB_XGEN(b.x)], 1u);
            asm volatile("s_waitcnt vmcnt(0)" ::: "memory");
        } else {
            XB_SPIN(xb_ld(&bar[XB_XGEN(b.x)]) == gen, bar);
            __builtin_amdgcn_fence(__ATOMIC_ACQUIRE, "agent");
            asm volatile("s_waitcnt vmcnt(0)" ::: "memory");
        }
    }
    __syncthreads();
}

struct Unit { int pm, pn, e, mb, nrows; const char* a; const char* b0; const char* b1; };
__device__ __forceinline__ int lane_id() { int l; asm volatile("v_mbcnt_lo_u32_b32 %0, -1, 0\n\tv_mbcnt_hi_u32_b32 %0, -1, %0" : "=v"(l)); return l; }
__device__ __forceinline__ void glds16(const char* sbase, unsigned voff, unsigned lds_dst) {
    unsigned keep;
    asm volatile("s_mov_b32 %0, m0\n\ts_mov_b32 m0, %3\n\ts_nop 0\n\tglobal_load_lds_dwordx4 %1, %2\n\ts_mov_b32 m0, %0" : "=&s"(keep) : "v"(voff), "s"(sbase), "s"(lds_dst) : "memory");
}
template <class Epi, class Sched>
__device__ __forceinline__ void gemm_phase(LAS unsigned char* lds, const int wid  , const Sched& S, const Epi& E, const int K, const int ldb) {
    const int lane = lane_id(), tid = wid * 64 + lane, wr = wid >> 2, wc = wid & 3, fr = lane & 15, fq = lane >> 4;
    const int nt = K / BK;
    int stR[2], stC[2]; unsigned voffB[2];
#pragma unroll
    for (int i = 0; i < 2; ++i) { int R, C; stage_rc(tid * 16 + i * 8192, R, C); stR[i] = R; stC[i] = C; const int Rb = Epi::PERM ? ((R & ~31) + perm32(R & 31)) : R; voffB[i] = (unsigned)(Rb * ldb + C) * 2u; }
    const size_t kstep = (size_t)(BK * 2);
    const unsigned ldsw = (unsigned)(size_t)lds + (unsigned)wid * 1024u;
    const int aoff = lds_byte(wr * 64 + fr, fq * 8), boff = lds_byte(wc * 32 + fr, fq * 8);
#define PG8_SA(b, h) (((b) * 2 + (h)) * HTB)
#define PG8_SB(b, h) ((4 + (b) * 2 + (h)) * HTB)
#define PG8_STAGE(bufoff, gbase, voff) do { _Pragma("unroll") for (int _i = 0; _i < 2; ++_i) glds16((const char*)(gbase), (voff)[_i], ldsw + (unsigned)(bufoff) + (unsigned)_i * 8192u); } while (0)
#define PG8_LDA(dst, b, h) do { _Pragma("unroll") for (int m = 0; m < 4; ++m) _Pragma("unroll") for (int k = 0; k < 2; ++k) dst[m][k] = *(const LAS bf16x8*)(lds + PG8_SA(b, h) + aoff + m * 2048 + k * 1024); } while (0)
#define PG8_LDB(dst, b, h) do { _Pragma("unroll") for (int n = 0; n < 2; ++n) _Pragma("unroll") for (int k = 0; k < 2; ++k) dst[n][k] = *(const LAS bf16x8*)(lds + PG8_SB(b, h) + boff + n * 2048 + k * 1024); } while (0)
#define PG8_MMA(ai, bj, At, Bt) do { __builtin_amdgcn_s_setprio(1); _Pragma("unroll") for (int m = 0; m < 4; ++m) _Pragma("unroll") for (int n = 0; n < 2; ++n) _Pragma("unroll") for (int k = 0; k < 2; ++k) \
        acc[ai][bj][m][n] = __builtin_amdgcn_mfma_f32_16x16x32_bf16(Bt[n][k], At[m][k], acc[ai][bj][m][n], 0, 0, 0); __builtin_amdgcn_s_setprio(0); } while (0)
#define PG8_WAIT_V(n) asm volatile("s_waitcnt vmcnt(" #n ")" ::: "memory")
#define PG8_WAIT_L(n) asm volatile("s_waitcnt lgkmcnt(" #n ")" ::: "memory")
#define PG8_BAR __builtin_amdgcn_s_barrier()
#define PG8_SCHED __builtin_amdgcn_sched_barrier(0)
    Unit cur, nxt; int ui = 0;
    if (!S.next(0, cur)) return;
    unsigned vcur[2][2], vnxt[2][2];
    S.avoff(cur, stR, stC, vcur);
    f32x4 acc[2][2][4][2];
#pragma unroll
    for (int a = 0; a < 2; ++a)
#pragma unroll
        for (int b = 0; b < 2; ++b)
#pragma unroll
            for (int m = 0; m < 4; ++m)
#pragma unroll
                for (int n = 0; n < 2; ++n) acc[a][b][m][n] = (f32x4){0.f, 0.f, 0.f, 0.f};
    bf16x8 At[4][2], B0[2][2], B1[2][2];
    PG8_STAGE(PG8_SB(0, 0), cur.b0, voffB); PG8_STAGE(PG8_SB(0, 1), cur.b1, voffB); PG8_STAGE(PG8_SA(0, 0), cur.a, vcur[0]); PG8_STAGE(PG8_SA(0, 1), cur.a, vcur[1]);
    if (wr == 1) PG8_BAR;
    PG8_WAIT_V(2); PG8_BAR;
    PG8_STAGE(PG8_SB(1, 0), cur.b0 + kstep, voffB); PG8_STAGE(PG8_SA(1, 0), cur.a + kstep, vcur[0]); PG8_STAGE(PG8_SB(1, 1), cur.b1 + kstep, voffB);
    PG8_WAIT_V(6); PG8_BAR;
    for (;;) {
        const bool has_next = S.next(ui + 1, nxt);
        if (has_next) S.avoff(nxt, stR, stC, vnxt);
        else {
#pragma unroll
            for (int h = 0; h < 2; ++h)
#pragma unroll
                for (int i = 0; i < 2; ++i) vnxt[h][i] = vcur[h][i];
        }
        const char* nA = has_next ? nxt.a : cur.a; const char* nB0 = has_next ? nxt.b0 : cur.b0; const char* nB1 = has_next ? nxt.b1 : cur.b1;
        for (int t = 0; t < nt; t += 2) {
            const bool last = (t == nt - 2);
            const char* a1 = cur.a + (size_t)(t + 1) * kstep;
            const char* a2 = last ? nA : cur.a + (size_t)(t + 2) * kstep;
            const char* b20 = last ? nB0 : cur.b0 + (size_t)(t + 2) * kstep; const char* b21 = last ? nB1 : cur.b1 + (size_t)(t + 2) * kstep;
            const char* a3 = a2 + kstep; const char* b30 = b20 + kstep; const char* b31 = b21 + kstep;
            unsigned v2[2][2];
#pragma unroll
            for (int h = 0; h < 2; ++h)
#pragma unroll
                for (int i = 0; i < 2; ++i) v2[h][i] = last ? vnxt[h][i] : vcur[h][i];
            PG8_LDB(B0, 0, 0); PG8_LDB(B1, 0, 1); PG8_SCHED; PG8_LDA(At, 0, 0); PG8_STAGE(PG8_SA(1, 1), a1, vcur[1]);
            PG8_WAIT_V(8); PG8_WAIT_L(0); PG8_BAR; PG8_MMA(0, 0, At, B0); PG8_MMA(0, 1, At, B1); PG8_BAR; PG8_SCHED;
            PG8_LDA(At, 0, 1); PG8_STAGE(PG8_SB(0, 0), b20, voffB); PG8_STAGE(PG8_SB(0, 1), b21, voffB); PG8_STAGE(PG8_SA(0, 0), a2, v2[0]);
            PG8_WAIT_V(8); PG8_WAIT_L(0); PG8_BAR; PG8_MMA(1, 0, At, B0); PG8_MMA(1, 1, At, B1); PG8_BAR; PG8_SCHED;
            PG8_LDB(B0, 1, 0); PG8_LDB(B1, 1, 1); PG8_SCHED; PG8_LDA(At, 1, 0); PG8_STAGE(PG8_SA(0, 1), a2, v2[1]);
            PG8_WAIT_V(8); PG8_WAIT_L(0); PG8_BAR; PG8_MMA(0, 0, At, B0); PG8_MMA(0, 1, At, B1); PG8_BAR; PG8_SCHED;
            PG8_LDA(At, 1, 1); PG8_STAGE(PG8_SB(1, 0), b30, voffB); PG8_STAGE(PG8_SB(1, 1), b31, voffB); PG8_STAGE(PG8_SA(1, 0), a3, v2[0]);
            PG8_WAIT_V(8); PG8_WAIT_L(0); PG8_BAR; PG8_MMA(1, 0, At, B0); PG8_MMA(1, 1, At, B1); PG8_BAR; PG8_SCHED;
        }
        if (wr == 0) PG8_BAR;
        E(acc, cur, wr, wc, fr, fq);
        if (!has_next) break;
#pragma unroll
        for (int a = 0; a < 2; ++a)
#pragma unroll
            for (int b = 0; b < 2; ++b)
#pragma unroll
                for (int m = 0; m < 4; ++m)
#pragma unroll
                    for (int n = 0; n < 2; ++n) acc[a][b][m][n] = (f32x4){0.f, 0.f, 0.f, 0.f};
        cur = nxt;
#pragma unroll
        for (int h = 0; h < 2; ++h)
#pragma unroll
            for (int i = 0; i < 2; ++i) vcur[h][i] = vnxt[h][i];
        ++ui;
        if (wr == 1) PG8_BAR;
    }
    PG8_WAIT_V(0);
    PG8_BAR;
#undef PG8_SA
#undef PG8_SB
#undef PG8_STAGE
#undef PG8_LDA
#undef PG8_LDB
#undef PG8_MMA
#undef PG8_WAIT_V
#undef PG8_WAIT_L
#undef PG8_BAR
#undef PG8_SCHED
}

__device__ __forceinline__ bool static_tile(int i, int G, int c, int nM, int nN, int& pm, int& pn) {
    const int nwg = nM * nN; const long L = (long)i * G + c; if (L >= nwg) return false;
    int wgid = (int)L; { const int q = nwg / NXCD, r = nwg % NXCD, xcd = wgid % NXCD, off = wgid / NXCD; wgid = (xcd < r ? xcd * (q + 1) : r * (q + 1) + (xcd - r) * q) + off; }
    const int nig = WGM * nN, gid = wgid / nig, fm = gid * WGM, gsz = (nM - fm) < WGM ? (nM - fm) : WGM;
    pm = fm + ((wgid % nig) % gsz); pn = (wgid % nig) / gsz; return true;
}
struct SchedTile {
    const char* A; const char* B; int lda, ldb, nM, nN, G, c; size_t a_pn_stride, b_pn_stride;
    __device__ __forceinline__ bool next(int i, Unit& u) const {
        if (!static_tile(i, G, c, nM, nN, u.pm, u.pn)) return false;
        u.e = 0; u.mb = 0; u.nrows = 256;
        u.a = A + (size_t)u.pm * 256 * lda * 2 + (size_t)u.pn * a_pn_stride; u.b0 = B + (size_t)u.pn * b_pn_stride; u.b1 = u.b0 + (size_t)128 * ldb * 2; return true;
    }
    __device__ __forceinline__ void avoff(const Unit&, const int (&R)[2], const int (&C)[2], unsigned (&v)[2][2]) const {
#pragma unroll
        for (int h = 0; h < 2; ++h)
#pragma unroll
            for (int i = 0; i < 2; ++i) v[h][i] = (unsigned)((h * 128 + R[i]) * lda + C[i]) * 2u;
    }
};
struct SchedSeg {
    const char* A0; const char* A1; const char* B0; const char* B1; int G, c;
    __device__ __forceinline__ bool next(int i, Unit& u) const {
        if (i > 1) return false;
        if (!static_tile(0, G, c, NTOK / 256, DM / 256, u.pm, u.pn)) return false;
        u.e = i; u.mb = 0; u.nrows = 256;
        u.a = (i ? A1 : A0) + (size_t)u.pm * 256 * 1024 * 2; u.b0 = (i ? B1 : B0) + (size_t)u.pn * 256 * 1024 * 2; u.b1 = u.b0 + (size_t)128 * 1024 * 2; return true;
    }
    __device__ __forceinline__ void avoff(const Unit&, const int (&R)[2], const int (&C)[2], unsigned (&v)[2][2]) const {
#pragma unroll
        for (int h = 0; h < 2; ++h)
#pragma unroll
            for (int i = 0; i < 2; ++i) v[h][i] = (unsigned)((h * 128 + R[i]) * 1024 + C[i]) * 2u;
    }
};
struct SchedMoe {
    const char* A; const char* B; const int* list; const LAS int* l_cnt; const LAS int* l_ub; const LAS int* l_roff; int G, c, ntl  ; bool gu;
    __device__ __forceinline__ bool next(int i, Unit& u) const {
        const int id = i * G + c; if (id >= __builtin_amdgcn_readfirstlane(l_ub[NE])) return false;
        int e = 0;
#pragma unroll 1
        for (int j = 1; j < NE; ++j) e += (id >= __builtin_amdgcn_readfirstlane(l_ub[j])) ? 1 : 0;
        const int loc = id - __builtin_amdgcn_readfirstlane(l_ub[e]), cnt = __builtin_amdgcn_readfirstlane(l_cnt[e]), nmb = (cnt + 255) >> 8, mb = loc % nmb, tn = loc / nmb;
        u.e = e; u.mb = mb; u.pn = tn; u.pm = (__builtin_amdgcn_readfirstlane(l_roff[e]) >> 8) + mb; u.nrows = (cnt - mb * 256) < 256 ? (cnt - mb * 256) : 256;
        if (gu) { u.a = A; u.b0 = B + ((size_t)e * 4096 + (size_t)tn * 128) * DM * 2; u.b1 = u.b0 + (size_t)2048 * DM * 2; }
        else    { u.a = A + (size_t)u.pm * 256 * DM * 2; u.b0 = B + ((size_t)e * 2048 + (size_t)tn * 256) * DM * 2; u.b1 = u.b0 + (size_t)128 * DM * 2; }
        return true;
    }
    __device__ __forceinline__ void avoff(const Unit& u, const int (&R)[2], const int (&C)[2], unsigned (&v)[2][2]) const {
#pragma unroll
        for (int h = 0; h < 2; ++h)
#pragma unroll
            for (int i = 0; i < 2; ++i) {
                const int r = h * 128 + R[i];
                if (gu) { const int idx = (r < u.nrows) ? (u.mb * 256 + r) : (u.mb * 256); const int tok = list[u.e * LCAP + idx] >> 2; v[h][i] = (unsigned)(tok * DM + C[i]) * 2u; }
                else v[h][i] = (unsigned)(r * DM + C[i]) * 2u;
            }
    }
};

#define EPI_LOOP_AM _Pragma("unroll") for (int ai = 0; ai < 2; ++ai) _Pragma("unroll") for (int m = 0; m < 4; ++m)
struct EpiProj {
    static constexpr bool PERM = true; bf16_t* O;
    __device__ __forceinline__ void operator()(const f32x4 (&acc)[2][2][4][2], const Unit& u, int wr, int wc, int fr, int fq) const {
        const int row0 = u.pm * BM + wr * 64 + fr, col0 = u.pn * BM + wc * 32 + 8 * fq; const bool sg = u.pn >= 16;
        EPI_LOOP_AM { bf16_t* rowp = O + (size_t)(row0 + ai * HALF + m * 16) * NIN + col0;
#pragma unroll
            for (int bj = 0; bj < 2; ++bj) { f32x4 v0 = acc[ai][bj][m][0], v1 = acc[ai][bj][m][1]; if (sg) { v0 = sigm4(v0); v1 = sigm4(v1); }
                u32x4 w; w.x = cvt_pk_bf16(v0[0], v0[1]); w.y = cvt_pk_bf16(v0[2], v0[3]); w.z = cvt_pk_bf16(v1[0], v1[1]); w.w = cvt_pk_bf16(v1[2], v1[3]); *(u32x4*)(rowp + bj * HALF) = w; } }
    }
};
struct EpiBf16Scale {
    static constexpr bool PERM = true; bf16_t* O; int ldc; const float* scale;
    __device__ __forceinline__ void operator()(const f32x4 (&acc)[2][2][4][2], const Unit& u, int wr, int wc, int fr, int fq) const {
        const int row0 = u.pm * BM + wr * 64 + fr, col0 = u.pn * BM + wc * 32 + 8 * fq;
        f32x4 sc[2][2];
#pragma unroll
        for (int bj = 0; bj < 2; ++bj)
#pragma unroll
            for (int n = 0; n < 2; ++n) sc[bj][n] = scale ? *(const f32x4*)(scale + col0 + bj * HALF + 4 * n) : (f32x4){1.f, 1.f, 1.f, 1.f};
        EPI_LOOP_AM { bf16_t* rowp = O + (size_t)(row0 + ai * HALF + m * 16) * ldc + col0;
#pragma unroll
            for (int bj = 0; bj < 2; ++bj) { const f32x4 v0 = acc[ai][bj][m][0] * sc[bj][0], v1 = acc[ai][bj][m][1] * sc[bj][1];
                u32x4 w; w.x = cvt_pk_bf16(v0[0], v0[1]); w.y = cvt_pk_bf16(v0[2], v0[3]); w.z = cvt_pk_bf16(v1[0], v1[1]); w.w = cvt_pk_bf16(v1[2], v1[3]); *(u32x4*)(rowp + bj * HALF) = w; } }
    }
};
struct EpiBranch {
    static constexpr bool PERM = true; const bf16_t* PROJ; float* M1; bf16_t* MB;
    __device__ __forceinline__ void operator()(const f32x4 (&acc)[2][2][4][2], const Unit& u, int wr, int wc, int fr, int fq) const {
        const int row0 = u.pm * BM + wr * 64 + fr, col0 = u.pn * BM + wc * 32 + 8 * fq; const int seg = u.e;
        EPI_LOOP_AM { const size_t row = (size_t)(row0 + ai * HALF + m * 16);
#pragma unroll
            for (int bj = 0; bj < 2; ++bj) { const int col = col0 + bj * HALF;
                const u32x4 gw = *(const u32x4*)(PROJ + row * NIN + 4096 + seg * 2048 + col);
                const f32x4 g0 = (f32x4){bf_lo(gw.x), bf_hi(gw.x), bf_lo(gw.y), bf_hi(gw.y)}, g1 = (f32x4){bf_lo(gw.z), bf_hi(gw.z), bf_lo(gw.w), bf_hi(gw.w)};
                f32x4 v0 = acc[ai][bj][m][0] * g0, v1 = acc[ai][bj][m][1] * g1; float* mp = M1 + row * DM + col;
                if (seg == 0) { *(f32x4*)mp = v0; *(f32x4*)(mp + 4) = v1; }
                else { v0 += *(const f32x4*)mp; v1 += *(const f32x4*)(mp + 4);
                    u32x4 w; w.x = cvt_pk_bf16(v0[0], v0[1]); w.y = cvt_pk_bf16(v0[2], v0[3]); w.z = cvt_pk_bf16(v1[0], v1[1]); w.w = cvt_pk_bf16(v1[2], v1[3]); *(u32x4*)(MB + row * DM + col) = w; } } }
    }
};
struct EpiWo {
    static constexpr bool PERM = false; const float* X; float* O;
    __device__ __forceinline__ void operator()(const f32x4 (&acc)[2][2][4][2], const Unit& u, int wr, int wc, int fr, int fq) const {
        const int row0 = u.pm * BM + wr * 64 + fr, col0 = u.pn * BM + wc * 32 + 4 * fq;
        EPI_LOOP_AM { const size_t off = (size_t)(row0 + ai * HALF + m * 16) * DM + col0;
#pragma unroll
            for (int bj = 0; bj < 2; ++bj)
#pragma unroll
                for (int n = 0; n < 2; ++n) { const f32x4 xv = *(const f32x4*)(X + off + bj * HALF + n * 16); *(f32x4*)(O + off + bj * HALF + n * 16) = xv * ALPHA + acc[ai][bj][m][n]; } }
    }
};
struct EpiGU {
    static constexpr bool PERM = true; bf16_t* O; const float* bias;
    __device__ __forceinline__ void operator()(const f32x4 (&acc)[2][2][4][2], const Unit& u, int wr, int wc, int fr, int fq) const {
        const int row0 = u.pm * BM + wr * 64 + fr, col0 = u.pn * 128 + wc * 32 + 8 * fq;
        f32x4 bg[2], bu[2];
#pragma unroll
        for (int n = 0; n < 2; ++n) { bg[n] = *(const f32x4*)(bias + (size_t)u.e * 4096 + col0 + 4 * n); bu[n] = *(const f32x4*)(bias + (size_t)u.e * 4096 + 2048 + col0 + 4 * n); }
        EPI_LOOP_AM { f32x4 o[2];
#pragma unroll
            for (int n = 0; n < 2; ++n) { const f32x4 g = acc[ai][0][m][n] + bg[n], up = acc[ai][1][m][n] + bu[n];
#pragma unroll
                for (int j = 0; j < 4; ++j) { const float gg = fminf(g[j], 7.0f), uu = fminf(fmaxf(up[j], -7.0f), 7.0f); o[n][j] = (uu + 1.0f) * (gg * sigm(1.702f * gg)); } }
            u32x4 w; w.x = cvt_pk_bf16(o[0][0], o[0][1]); w.y = cvt_pk_bf16(o[0][2], o[0][3]); w.z = cvt_pk_bf16(o[1][0], o[1][1]); w.w = cvt_pk_bf16(o[1][2], o[1][3]);
            *(u32x4*)(O + (size_t)(row0 + ai * HALF + m * 16) * DM + col0) = w; }
    }
};
struct EpiDown {
    static constexpr bool PERM = true; bf16_t* O; const float* bias; const int* list;
    __device__ __forceinline__ void operator()(const f32x4 (&acc)[2][2][4][2], const Unit& u, int wr, int wc, int fr, int fq) const {
        const int col0 = u.pn * BM + wc * 32 + 8 * fq;
        f32x4 bv[2][2];
#pragma unroll
        for (int bj = 0; bj < 2; ++bj)
#pragma unroll
            for (int n = 0; n < 2; ++n) bv[bj][n] = *(const f32x4*)(bias + (size_t)u.e * DM + col0 + bj * HALF + 4 * n);
        EPI_LOOP_AM { const int r = ai * HALF + wr * 64 + m * 16 + fr;
            if (r < u.nrows) { const int dst = list[u.e * LCAP + u.mb * 256 + r]; bf16_t* rowp = O + (size_t)dst * DM + col0;
#pragma unroll
                for (int bj = 0; bj < 2; ++bj) { const f32x4 v0 = acc[ai][bj][m][0] + bv[bj][0], v1 = acc[ai][bj][m][1] + bv[bj][1];
                    u32x4 w; w.x = cvt_pk_bf16(v0[0], v0[1]); w.y = cvt_pk_bf16(v0[2], v0[3]); w.z = cvt_pk_bf16(v1[0], v1[1]); w.w = cvt_pk_bf16(v1[2], v1[3]); *(u32x4*)(rowp + bj * HALF) = w; } } }
    }
};
struct EpiPg {
    static constexpr bool PERM = false; const float* H2; const bf16_t* PLEB; const float* bias; float* O;
    __device__ __forceinline__ void operator()(const f32x4 (&acc)[2][2][4][2], const Unit& u, int wr, int wc, int fr, int fq) const {
        const int row0 = u.pm * BM + wr * 64 + fr, col0 = u.pn * BM + wc * 32 + 4 * fq;
        f32x4 bv[2][2];
#pragma unroll
        for (int bj = 0; bj < 2; ++bj)
#pragma unroll
            for (int n = 0; n < 2; ++n) bv[bj][n] = *(const f32x4*)(bias + col0 + bj * HALF + n * 16);
        EPI_LOOP_AM { const size_t off = (size_t)(row0 + ai * HALF + m * 16) * DM + col0;
#pragma unroll
            for (int bj = 0; bj < 2; ++bj)
#pragma unroll
                for (int n = 0; n < 2; ++n) { const size_t o = off + bj * HALF + n * 16; const f32x4 hv = *(const f32x4*)(H2 + o); const u32x2 pw = *(const u32x2*)(PLEB + o);
                    const f32x4 pv = (f32x4){bf_lo(pw.x), bf_hi(pw.x), bf_lo(pw.y), bf_hi(pw.y)};
                    *(f32x4*)(O + o) = hv * ALPHA + sigm4(acc[ai][bj][m][n] + bv[bj][n]) * pv; } }
    }
};
struct Args { const float* in[24]; float* out; unsigned char* ws; int ph_lo, ph_hi; };
struct Frame {
    LAS unsigned char* lds; volatile LAS int* lctl; gu32* ctl;
    int wave, vcu, G;
    const Args* a; float* out; unsigned char* ws;
};
#define FIN(i) (F.a->in[i])
#define LDS_WAIT() asm volatile("s_waitcnt lgkmcnt(0)" ::: "memory")
__device__ __forceinline__ float wave_sum(float v) {
#pragma unroll
    for (int o = 1; o < 64; o <<= 1) v += __shfl_xor(v, o);
    return v;
}
__device__ __forceinline__ unsigned pk2(float lo, float hi) { return cvt_pk_bf16(lo, hi); }

__device__ __forceinline__ void p0_item(const float* W, int K, int N, bf16_t* WT, LAS unsigned char* scr, int item, int lane) {
    const int nblk = N >> 6, kb = item / nblk, nb = item - kb * nblk, k0 = kb * 64, n0 = nb * 64, nc = lane & 15, q = lane >> 4;
    f32x4 v[16];
#pragma unroll
    for (int i = 0; i < 16; ++i) v[i] = *(const f32x4*)(W + (size_t)(k0 + 16 * q + i) * N + n0 + 4 * nc);
#pragma unroll
    for (int j = 0; j < 4; ++j) {
        u32x4 w0, w1;
        w0.x = pk2(v[0][j], v[1][j]); w0.y = pk2(v[2][j], v[3][j]); w0.z = pk2(v[4][j], v[5][j]); w0.w = pk2(v[6][j], v[7][j]);
        w1.x = pk2(v[8][j], v[9][j]); w1.y = pk2(v[10][j], v[11][j]); w1.z = pk2(v[12][j], v[13][j]); w1.w = pk2(v[14][j], v[15][j]);
        LAS unsigned char* p = scr + (4 * nc + j) * 144 + 32 * q;
        *(LAS u32x4*)p = w0; *(LAS u32x4*)(p + 16) = w1;
    }
    LDS_WAIT(); asm volatile("" ::: "memory");
#pragma unroll
    for (int jj = 0; jj < 8; ++jj) { const int n = (lane >> 3) + 8 * jj, c = lane & 7; const u32x4 o = *(const LAS u32x4*)(scr + n * 144 + c * 16);
        *(u32x4*)(WT + (size_t)(n0 + n) * K + k0 + 8 * c) = o; }
    LDS_WAIT(); asm volatile("" ::: "memory");
}
__device__ __forceinline__ void p0_prologue(Frame& F) {
    const int lane = lane_id(), tid = F.wave * 64 + lane;
    LAS unsigned char* scr = F.lds + F.wave * 16384;
    const int gw = F.vcu * NWAVES + F.wave, NGW = F.G * NWAVES;
    unsigned char* ws = F.ws;
    constexpr int I_IN = 32 * 128, I_POOL = 16, I_BR = 16 * 32, I_SQ = 32 * 32, I_GU = 32 * 64, I_PLE = 4 * 32;
    constexpr int NITEMS = I_IN + 4 * I_POOL + 2 * I_BR + 2 * I_SQ + 32 * I_GU + 32 * I_SQ + I_PLE;
    for (int it = gw; it < NITEMS; it += NGW) {
        int r = it;
        if (r < 32 * I_GU) { const int e = r / I_GU; p0_item(FIN(13) + (size_t)e * DM * 4096, DM, 4096, (bf16_t*)(ws + WS_WGU) + (size_t)e * 4096 * DM, scr, r - e * I_GU, lane); continue; } r -= 32 * I_GU;
        if (r < 32 * I_SQ) { const int e = r / I_SQ; p0_item(FIN(15) + (size_t)e * DM * DM, DM, DM, (bf16_t*)(ws + WS_WDN) + (size_t)e * DM * DM, scr, r - e * I_SQ, lane); continue; } r -= 32 * I_SQ;
        if (r < I_IN) { p0_item(FIN(2), DM, NIN, (bf16_t*)(ws + WS_WIN), scr, r, lane); continue; } r -= I_IN;
        if (r < 4 * I_POOL) { const int g = r / I_POOL; p0_item(FIN(3) + g * 65536, 256, 256, (bf16_t*)(ws + WS_WPOOL) + g * 65536, scr, r - g * I_POOL, lane); continue; } r -= 4 * I_POOL;
        if (r < I_BR) { p0_item(FIN(6), 1024, DM, (bf16_t*)(ws + WS_WBRA), scr, r, lane); continue; } r -= I_BR;
        if (r < I_BR) { p0_item(FIN(7), 1024, DM, (bf16_t*)(ws + WS_WBRB), scr, r, lane); continue; } r -= I_BR;
        if (r < I_SQ) { p0_item(FIN(8), DM, DM, (bf16_t*)(ws + WS_WO), scr, r, lane); continue; } r -= I_SQ;
        if (r < I_SQ) { p0_item(FIN(19), DM, DM, (bf16_t*)(ws + WS_WPG), scr, r, lane); continue; } r -= I_SQ;
        p0_item(FIN(21), PLE, DM, (bf16_t*)(ws + WS_WPLE), scr, r, lane);
    }
    const size_t gt = (size_t)F.vcu * 512 + tid, NT = (size_t)F.G * 512;
    for (size_t i = gt; i < (size_t)NTOK * DM / 8; i += NT) { const f32x4 a = *(const f32x4*)(FIN(0) + i * 8), b = *(const f32x4*)(FIN(0) + i * 8 + 4);
        u32x4 w; w.x = pk2(a[0], a[1]); w.y = pk2(a[2], a[3]); w.z = pk2(b[0], b[1]); w.w = pk2(b[2], b[3]); *(u32x4*)((bf16_t*)(ws + WS_XB) + i * 8) = w; }
    for (size_t i = gt; i < (size_t)NTOK * PLE / 8; i += NT) { const f32x4 a = *(const f32x4*)(FIN(1) + i * 8), b = *(const f32x4*)(FIN(1) + i * 8 + 4);
        u32x4 w; w.x = pk2(a[0], a[1]); w.y = pk2(a[2], a[3]); w.z = pk2(b[0], b[1]); w.w = pk2(b[2], b[3]); *(u32x4*)((bf16_t*)(ws + WS_PB) + i * 8) = w; }
    for (size_t i = gt; i < (size_t)NE * DM; i += NT) { const int e = (int)(i >> 11), c = (int)(i & 2047); ((float*)(ws + WS_WRT))[i] = FIN(11)[c * NE + e]; }
}

__device__ __forceinline__ void unpack8(const u32x4 w, float (&f)[8]) { f[0] = bf_lo(w.x); f[1] = bf_hi(w.x); f[2] = bf_lo(w.y); f[3] = bf_hi(w.y); f[4] = bf_lo(w.z); f[5] = bf_hi(w.z); f[6] = bf_lo(w.w); f[7] = bf_hi(w.w); }
__device__ __forceinline__ u32x4 pack8(const float (&f)[8]) { u32x4 w; w.x = pk2(f[0], f[1]); w.y = pk2(f[2], f[3]); w.z = pk2(f[4], f[5]); w.w = pk2(f[6], f[7]); return w; }
__device__ __forceinline__ void p2_poolconv(Frame& F) {
    const int lane = lane_id(), tid = F.wave * 64 + lane;
    const bf16_t* PROJ = (const bf16_t*)(F.ws + WS_PROJ); bf16_t* POOLED = (bf16_t*)(F.ws + WS_POOLED); bf16_t* BCONV = (bf16_t*)(F.ws + WS_BCONV); const float* conv_w = FIN(5);
    const int gt = F.vcu * 512 + tid, NT = F.G * 512;
    for (int idx = gt; idx < NTOK * 128; idx += NT) {
        const int t = idx >> 7, ch = (idx & 127) * 8, tl = t & (SEQL - 1), g = ch >> 8, w = 2 << g, n = (tl + 1 < w) ? tl + 1 : w;
        float u[8], s[8], x[8];
        unpack8(*(const u32x4*)(PROJ + (size_t)t * NIN + ch), u);
#pragma unroll
        for (int q = 0; q < 8; ++q) s[q] = u[q];
        for (int j = 1; j < n; ++j) { unpack8(*(const u32x4*)(PROJ + (size_t)(t - j) * NIN + ch), x);
#pragma unroll
            for (int q = 0; q < 8; ++q) s[q] += x[q]; }
        const float inv = 1.0f / (float)n;
#pragma unroll
        for (int q = 0; q < 8; ++q) s[q] = s[q] * inv - u[q];
        *(u32x4*)(POOLED + (size_t)t * 1024 + ch) = pack8(s);
        float acc[8], cc[8], cv[8];
#pragma unroll
        for (int q = 0; q < 8; ++q) acc[q] = 0.f;
#pragma unroll
        for (int j = 0; j < 3; ++j) { const int d = 2 - j;
            if (tl - d >= 0) { unpack8(*(const u32x4*)(PROJ + (size_t)(t - d) * NIN + 2048 + ch), cc); unpack8(*(const u32x4*)(PROJ + (size_t)(t - d) * NIN + 3072 + ch), cv);
                const f32x4 w0 = *(const f32x4*)(conv_w + j * 1024 + ch), w1 = *(const f32x4*)(conv_w + j * 1024 + ch + 4);
#pragma unroll
                for (int q = 0; q < 4; ++q) { acc[q] += w0[q] * cc[q] * cv[q]; acc[q + 4] += w1[q] * cc[q + 4] * cv[q + 4]; } } }
        unpack8(*(const u32x4*)(PROJ + (size_t)t * NIN + 1024 + ch), x);
#pragma unroll
        for (int q = 0; q < 8; ++q) acc[q] *= x[q];
        *(u32x4*)(BCONV + (size_t)t * 1024 + ch) = pack8(acc);
    }
}

__device__ __forceinline__ void p6_ln1_router(Frame& F) {
    const float* PRE1 = (const float*)(F.ws + WS_PRE1); float* X1 = (float*)(F.ws + WS_X1); bf16_t* X1B = (bf16_t*)(F.ws + WS_X1B);
    const float* WRT = (const float*)(F.ws + WS_WRT); const float* g1 = FIN(9); const float* b1 = FIN(10); const float* b_router = FIN(12);
    int* cnt = (int*)(F.ctl + CW_CNT); int* list = (int*)(F.ws + WS_LIST); int* tok_e = (int*)(F.ws + WS_TOK); float* tok_gate = (float*)(F.ws + WS_TOK + 128 * 1024);
    const int lane = lane_id(), tid = F.wave * 64 + lane, row_base = F.vcu * 32 + F.wave * 4;
    float xr[4][32];
#pragma unroll
    for (int r = 0; r < 4; ++r) {
        const size_t ro = (size_t)(row_base + r) * DM; float s = 0.f;
#pragma unroll
        for (int j = 0; j < 8; ++j) { const f32x4 v = *(const f32x4*)(PRE1 + ro + 256 * j + 4 * lane); xr[r][4 * j] = v[0]; xr[r][4 * j + 1] = v[1]; xr[r][4 * j + 2] = v[2]; xr[r][4 * j + 3] = v[3]; s += (v[0] + v[1]) + (v[2] + v[3]); }
        const float mean = wave_sum(s) * (1.0f / DM); float q = 0.f;
#pragma unroll
        for (int k = 0; k < 32; ++k) { xr[r][k] -= mean; q += xr[r][k] * xr[r][k]; }
        const float rstd = rsqrtf(wave_sum(q) * (1.0f / DM) + LN_EPS);
#pragma unroll
        for (int j = 0; j < 8; ++j) { const f32x4 gv = *(const f32x4*)(g1 + 256 * j + 4 * lane), bv = *(const f32x4*)(b1 + 256 * j + 4 * lane); f32x4 y;
#pragma unroll
            for (int k = 0; k < 4; ++k) { y[k] = xr[r][4 * j + k] * rstd * gv[k] + bv[k]; xr[r][4 * j + k] = y[k]; }
            *(f32x4*)(X1 + ro + 256 * j + 4 * lane) = y; u32x2 w; w.x = pk2(y[0], y[1]); w.y = pk2(y[2], y[3]); *(u32x2*)(X1B + ro + 256 * j + 4 * lane) = w; }
    }
    float lgt[4] = {0.f, 0.f, 0.f, 0.f};
#pragma unroll 1
    for (int pass = 0; pass < 2; ++pass) {
        __syncthreads();
        for (int i = tid; i < 16 * DM / 4; i += 512) *(LAS f32x4*)(F.lds + (size_t)i * 16) = *(const f32x4*)(WRT + (size_t)pass * 16 * DM + (size_t)i * 4);
        __syncthreads();
#pragma unroll 1
        for (int e = 0; e < 16; ++e) {
            float a0 = 0.f, a1 = 0.f, a2 = 0.f, a3 = 0.f;
#pragma unroll
            for (int j = 0; j < 8; ++j) { const f32x4 w = *(const LAS f32x4*)(F.lds + ((size_t)e * DM + 256 * j + 4 * lane) * 4);
#pragma unroll
                for (int k = 0; k < 4; ++k) { a0 = fmaf(xr[0][4 * j + k], w[k], a0); a1 = fmaf(xr[1][4 * j + k], w[k], a1); a2 = fmaf(xr[2][4 * j + k], w[k], a2); a3 = fmaf(xr[3][4 * j + k], w[k], a3); } }
            a0 = wave_sum(a0); a1 = wave_sum(a1); a2 = wave_sum(a2); a3 = wave_sum(a3);
            if (lane == pass * 16 + e) { lgt[0] = a0; lgt[1] = a1; lgt[2] = a2; lgt[3] = a3; }
        }
    }
    const float br = (lane < 32) ? b_router[lane & 31] : 0.f;
#pragma unroll
    for (int r = 0; r < 4; ++r) {
        float val = (lane < 32) ? lgt[r] + br : -3.0e38f; float tv[4]; int te[4];
#pragma unroll
        for (int k = 0; k < 4; ++k) { float bv = val; int bi = lane;
#pragma unroll
            for (int o = 32; o >= 1; o >>= 1) { const float ov = __shfl_xor(bv, o); const int oi = __shfl_xor(bi, o); if (ov > bv || (ov == bv && oi < bi)) { bv = ov; bi = oi; } }
            tv[k] = bv; te[k] = bi; if (lane == bi) val = -3.0e38f; }
        const float e1 = __expf(tv[1] - tv[0]), e2 = __expf(tv[2] - tv[0]), e3 = __expf(tv[3] - tv[0]); const float inv = 1.0f / (1.0f + e1 + e2 + e3);
        if (lane < 4) { const int ek = lane == 0 ? te[0] : lane == 1 ? te[1] : lane == 2 ? te[2] : te[3]; const float gk = (lane == 0 ? 1.0f : lane == 1 ? e1 : lane == 2 ? e2 : e3) * inv;
            const int t = row_base + r; const int rank = atomicAdd(&cnt[ek], 1); list[ek * LCAP + rank] = t * 4 + lane; tok_e[t * 4 + lane] = ek; tok_gate[t * 4 + lane] = gk; }
    }
}

template <int MODE  >
__device__ __forceinline__ void row_ln(Frame& F) {
    const float* src = MODE == 0 ? (const float*)(F.ws + WS_X1) : F.out; float* dst = MODE == 0 ? (float*)(F.ws + WS_H2) : F.out; bf16_t* dstb = (bf16_t*)(F.ws + WS_H2B);
    const bf16_t* Y = (const bf16_t*)(F.ws + WS_Y); const float* tok_gate = (const float*)(F.ws + WS_TOK + 128 * 1024);
    const float* g = MODE == 0 ? FIN(17) : FIN(22); const float* b = MODE == 0 ? FIN(18) : FIN(23);
    const int lane = lane_id(), gw = F.vcu * NWAVES + F.wave, NGW = F.G * NWAVES;
    for (int t = gw; t < NTOK; t += NGW) {
        const size_t ro = (size_t)t * DM; float v[32];
#pragma unroll
        for (int j = 0; j < 4; ++j) { const f32x4 a = *(const f32x4*)(src + ro + 512 * j + 8 * lane), c = *(const f32x4*)(src + ro + 512 * j + 8 * lane + 4);
#pragma unroll
            for (int k = 0; k < 4; ++k) { v[8 * j + k] = a[k]; v[8 * j + 4 + k] = c[k]; } }
        if (MODE == 0) {
            const f32x4 gt = *(const f32x4*)(tok_gate + t * 4);
#pragma unroll
            for (int k = 0; k < 32; ++k) v[k] *= ALPHA;
#pragma unroll
            for (int kk = 0; kk < 4; ++kk) {
#pragma unroll
                for (int j = 0; j < 4; ++j) { float y[8]; unpack8(*(const u32x4*)(Y + ((size_t)t * 4 + kk) * DM + 512 * j + 8 * lane), y);
#pragma unroll
                    for (int k = 0; k < 8; ++k) v[8 * j + k] = fmaf(gt[kk], y[k], v[8 * j + k]); } }
        }
        float s = 0.f;
#pragma unroll
        for (int k = 0; k < 32; ++k) s += v[k];
        const float mean = wave_sum(s) * (1.0f / DM); float q = 0.f;
#pragma unroll
        for (int k = 0; k < 32; ++k) { v[k] -= mean; q += v[k] * v[k]; }
        const float rstd = rsqrtf(wave_sum(q) * (1.0f / DM) + LN_EPS);
#pragma unroll
        for (int j = 0; j < 4; ++j) { const int c0 = 512 * j + 8 * lane; const f32x4 g0 = *(const f32x4*)(g + c0), g1 = *(const f32x4*)(g + c0 + 4), b0 = *(const f32x4*)(b + c0), b1 = *(const f32x4*)(b + c0 + 4); float y[8];
#pragma unroll
            for (int k = 0; k < 4; ++k) { y[k] = v[8 * j + k] * rstd * g0[k] + b0[k]; y[4 + k] = v[8 * j + 4 + k] * rstd * g1[k] + b1[k]; }
            *(f32x4*)(dst + ro + c0) = (f32x4){y[0], y[1], y[2], y[3]}; *(f32x4*)(dst + ro + c0 + 4) = (f32x4){y[4], y[5], y[6], y[7]};
            if (MODE == 0) *(u32x4*)(dstb + ro + c0) = pack8(y); }
    }
}

__device__ __forceinline__ void moe_tables(Frame& F) {
    const int tid = F.wave * 64 + lane_id();
    if (tid == 0) {
        int ub7 = 0, ub8 = 0, roff = 0;
        for (int e = 0; e < NE; ++e) { const int c = (int)__hip_atomic_load(F.ctl + CW_CNT + e, __ATOMIC_RELAXED, __HIP_MEMORY_SCOPE_AGENT); const int nmb = (c + 255) >> 8;
            F.lctl[L_CNT / 4 + e] = c; F.lctl[L_UB7 / 4 + e] = ub7; F.lctl[L_UB8 / 4 + e] = ub8; F.lctl[L_ROFF / 4 + e] = roff; ub7 += nmb * 16; ub8 += nmb * 8; roff += nmb * 256; }
        F.lctl[L_UB7 / 4 + NE] = ub7; F.lctl[L_UB8 / 4 + NE] = ub8; F.lctl[L_ROFF / 4 + NE] = roff;
    }
    __syncthreads();
}

__global__ void __launch_bounds__(NWAVES * 64, 2) fwd(Args args) {
    extern __shared__ __attribute__((aligned(16))) unsigned char lds_raw[];
    Frame F;
    F.lds = (LAS unsigned char*)lds_raw; F.lctl = (volatile LAS int*)(F.lds + LDSCTL_OFF);
    F.wave = __builtin_amdgcn_readfirstlane((int)threadIdx.x >> 6);
    F.G = gridDim.x; { const int bx = blockIdx.x; F.vcu = (F.G % 8 == 0) ? (bx % 8) * (F.G / 8) + bx / 8 : bx; }
    F.a = &args; F.out = args.out; F.ws = args.ws; F.ctl = (gu32*)(args.ws + WS_CTL);
    unsigned char* ws = args.ws;
    for (int u = (int)threadIdx.x; u < (LDS_BYTES - LDSCTL_OFF) / 4; u += NWAVES * 64) ((LAS unsigned*)(F.lds + LDSCTL_OFF))[u] = 0u;
    __syncthreads();
    XcdBarrier bar = xcd_barrier_post((unsigned*)(F.ctl + CW_BAR), (volatile LAS unsigned*)(F.lds + LDSCTL_OFF + L_BARST));
    const int lo = args.ph_lo, hi = args.ph_hi;
#define IN(k) (lo <= (k) && (k) < hi)
#define SEAM(k) do { if (IN(k) && IN((k) + 1)) xcd_barrier(bar); } while (0)
    const int c = (int)blockIdx.x;

    if (IN(0)) { p0_prologue(F); }
    SEAM(0);
    if (IN(1)) {
        { SchedTile S{(const char*)(ws + WS_XB), (const char*)(ws + WS_WIN), DM, DM, NTOK / 256, NIN / 256, F.G, c, 0, (size_t)256 * DM * 2};
          EpiProj E{(bf16_t*)(ws + WS_PROJ)}; gemm_phase(F.lds, F.wave, S, E, DM, DM); }
        { SchedTile S{(const char*)(ws + WS_PB), (const char*)(ws + WS_WPLE), PLE, PLE, NTOK / 256, DM / 256, F.G, c, 0, (size_t)256 * PLE * 2};
          EpiBf16Scale E{(bf16_t*)(ws + WS_PLEB), DM, nullptr}; gemm_phase(F.lds, F.wave, S, E, PLE, PLE); }
    }
    SEAM(1);
    if (IN(2)) { p2_poolconv(F); }
    SEAM(2);
    if (IN(3)) {
        SchedTile S{(const char*)(ws + WS_POOLED), (const char*)(ws + WS_WPOOL), 1024, 256, NTOK / 256, 4, F.G, c, (size_t)256 * 2, (size_t)256 * 256 * 2};
        EpiBf16Scale E{(bf16_t*)(ws + WS_ABUF), 1024, FIN(4)}; gemm_phase(F.lds, F.wave, S, E, 256, 256);
    }
    SEAM(3);
    if (IN(4)) {
        SchedSeg S{(const char*)(ws + WS_ABUF), (const char*)(ws + WS_BCONV), (const char*)(ws + WS_WBRA), (const char*)(ws + WS_WBRB), F.G, c};
        EpiBranch E{(const bf16_t*)(ws + WS_PROJ), (float*)(ws + WS_M1), (bf16_t*)(ws + WS_MB)}; gemm_phase(F.lds, F.wave, S, E, 1024, 1024);
    }
    SEAM(4);
    if (IN(5)) {
        SchedTile S{(const char*)(ws + WS_MB), (const char*)(ws + WS_WO), DM, DM, NTOK / 256, DM / 256, F.G, c, 0, (size_t)256 * DM * 2};
        EpiWo E{FIN(0), (float*)(ws + WS_PRE1)}; gemm_phase(F.lds, F.wave, S, E, DM, DM);
    }
    SEAM(5);
    if (IN(6)) { p6_ln1_router(F); }
    SEAM(6);
    if (IN(7) || IN(8)) moe_tables(F);
    if (IN(7)) {
        SchedMoe S{(const char*)(ws + WS_X1B), (const char*)(ws + WS_WGU), (const int*)(ws + WS_LIST), (const LAS int*)(F.lds + LDSCTL_OFF + L_CNT), (const LAS int*)(F.lds + LDSCTL_OFF + L_UB7), (const LAS int*)(F.lds + LDSCTL_OFF + L_ROFF), F.G, F.vcu, 16, true};
        EpiGU E{(bf16_t*)(ws + WS_ACT), FIN(14)}; gemm_phase(F.lds, F.wave, S, E, DM, DM);
    }
    SEAM(7);
    if (IN(8)) {
        SchedMoe S{(const char*)(ws + WS_ACT), (const char*)(ws + WS_WDN), (const int*)(ws + WS_LIST), (const LAS int*)(F.lds + LDSCTL_OFF + L_CNT), (const LAS int*)(F.lds + LDSCTL_OFF + L_UB8), (const LAS int*)(F.lds + LDSCTL_OFF + L_ROFF), F.G, F.vcu, 8, false};
        EpiDown E{(bf16_t*)(ws + WS_Y), FIN(16), (const int*)(ws + WS_LIST)}; gemm_phase(F.lds, F.wave, S, E, DM, DM);
    }
    SEAM(8);
    if (IN(9)) { row_ln<0>(F); }
    SEAM(9);
    if (IN(10)) {
        SchedTile S{(const char*)(ws + WS_H2B), (const char*)(ws + WS_WPG), DM, DM, NTOK / 256, DM / 256, F.G, c, 0, (size_t)256 * DM * 2};
        EpiPg E{(const float*)(ws + WS_H2), (const bf16_t*)(ws + WS_PLEB), FIN(20), F.out}; gemm_phase(F.lds, F.wave, S, E, DM, DM);
    }
    SEAM(10);
    if (IN(11)) { row_ln<1>(F); }
#undef IN
#undef SEAM
}

inline bool launch(void* const* d_in, float* out, void* d_ws, size_t ws_size, hipStream_t stream, int lo, int hi) {
    static int grid = 0;
    if (grid == 0) {
        int dev = 0, cus = 0;
        if (ws_size < WS_END || hipGetDevice(&dev) != hipSuccess || hipDeviceGetAttribute(&cus, hipDeviceAttributeMultiprocessorCount, dev) != hipSuccess) { fprintf(stderr, "fp::launch: setup failed (ws %zu)\n", ws_size); grid = -1; return false; }
        if (hipFuncSetAttribute((const void*)fwd, hipFuncAttributeMaxDynamicSharedMemorySize, LDS_BYTES) != hipSuccess) { fprintf(stderr, "fp::launch: hipFuncSetAttribute failed\n"); grid = -1; return false; }
        if (cus != 256) { fprintf(stderr, "fp::launch: built for 256 CUs, device has %d\n", cus); grid = -1; return false; }
        grid = cus;
    }
    if (grid < 0) return false;
    Args a{};
    for (int i = 0; i < 24; ++i) a.in[i] = (const float*)d_in[i];
    a.out = out; a.ws = (unsigned char*)d_ws; a.ph_lo = lo; a.ph_hi = hi;
    hipLaunchKernelGGL(fwd, dim3(grid), dim3(NWAVES * 64), LDS_BYTES, stream, a);
    return hipPeekAtLastError() == hipSuccess;
}
}
extern "C" void kernel_launch(void* const* d_in, const int* in_sizes, int n_in, void* d_out, int out_size, void* d_ws, size_t ws_size, hipStream_t stream) {
    if (n_in != 24 || out_size != fp::NTOK * fp::DM) { fprintf(stderr, "kernel_launch: unexpected shapes (n_in %d out %d)\n", n_in, out_size); return; }
    if (hipMemsetAsync((char*)d_ws + fp::WS_CTL, 0, fp::CTL_ZERO_BYTES, stream) != hipSuccess) return;
    fp::launch(d_in, (float*)d_out, d_ws, ws_size, stream, 0, 12);
}
```

```cpp
#include <hip/hip_runtime.h>
#include <cstdio>
#include <cstdint>
namespace fp {
#define LAS __attribute__((address_space(3)))
#define GAS __attribute__((address_space(1)))
typedef unsigned short bf16_t;
typedef short bf16x8 __attribute__((ext_vector_type(8)));
typedef float f32x4 __attribute__((ext_vector_type(4)));
typedef float f32x2 __attribute__((ext_vector_type(2)));
typedef unsigned u32x4 __attribute__((ext_vector_type(4)));
typedef unsigned u32x2 __attribute__((ext_vector_type(2)));
typedef GAS unsigned gu32;

constexpr int NTOK = 8192, DM = 2048, NIN = 8192, NE = 32, SEQL = 2048, PLE = 256, LCAP = 8192;
constexpr float ALPHA = 1.189207115002721f, LN_EPS = 1e-5f;
constexpr int NWAVES = 8;
constexpr int BM = 256, BK = 64, HALF = 128, HTB = HALF * BK * 2, NXCD = 8, WGM = 8;

constexpr size_t MiB = 1u << 20;
constexpr size_t WS_CTL = 0, CTL_ZERO_BYTES = 1 * MiB;
constexpr size_t WS_LIST = 1 * MiB, WS_TOK = 2 * MiB, WS_WPOOL = 3 * MiB, WS_WPLE = 4 * MiB, WS_PB = 5 * MiB, WS_WBRA = 9 * MiB, WS_WBRB = 13 * MiB, WS_WO = 17 * MiB, WS_WPG = 25 * MiB,
                 WS_WIN = 33 * MiB, WS_XB = 65 * MiB, WS_PLEB = 97 * MiB, WS_POOLED = 129 * MiB, WS_BCONV = 145 * MiB, WS_ABUF = 161 * MiB, WS_MB = 177 * MiB, WS_X1B = 209 * MiB,
                 WS_H2B = 241 * MiB, WS_M1 = 273 * MiB, WS_PRE1 = 337 * MiB, WS_X1 = 401 * MiB, WS_H2 = 465 * MiB, WS_PROJ = 529 * MiB, WS_Y = 657 * MiB, WS_ACT = 785 * MiB,
                 WS_WDN = 945 * MiB, WS_WGU = 1201 * MiB, WS_END = 1713 * MiB;
constexpr size_t WS_WRT = WS_TOK + 512 * 1024;
constexpr int CW_TMO = 0, CW_BAR = 4096, CW_CNT = 8192;

constexpr int RING_BYTES = 131072, LDSCTL_OFF = RING_BYTES, LDS_BYTES = 147456;
constexpr int L_CNT = 0, L_UB7 = 256, L_UB8 = 512, L_ROFF = 768, L_BARST = 1024;

__device__ __forceinline__ int lds_byte(int r, int c) { const int st = (r >> 4) * 2 + (c >> 5), rr = r & 15, cc = c & 31, ob = rr * 64 + cc * 2; return st * 1024 + (ob ^ (((ob >> 9) & 1) << 5)); }
__device__ __forceinline__ void stage_rc(int b, int& R, int& C) { const int st = b / 1024, sb = b % 1024, swz = sb ^ (((sb >> 9) & 1) << 5); R = (st >> 1) * 16 + swz / 64; C = (st & 1) * 32 + (swz % 64) / 2; }
__device__ __forceinline__ int perm32(int rho) { const int n = rho >> 4, i = rho & 15; return 8 * (i >> 2) + 4 * n + (i & 3); }
__device__ __forceinline__ unsigned cvt_pk_bf16(float lo, float hi) { unsigned r; asm volatile("v_cvt_pk_bf16_f32 %0, %1, %2" : "=v"(r) : "v"(lo), "v"(hi)); return r; }
__device__ __forceinline__ float bf_lo(unsigned w) { return __uint_as_float(w << 16); }
__device__ __forceinline__ float bf_hi(unsigned w) { return __uint_as_float(w & 0xffff0000u); }
__device__ __forceinline__ float sigm(float v) { return __builtin_amdgcn_rcpf(1.0f + __expf(-v)); }
__device__ __forceinline__ f32x4 sigm4(f32x4 v) { return (f32x4){sigm(v[0]), sigm(v[1]), sigm(v[2]), sigm(v[3])}; }

#define XB_TMO      128
#define XB_XCNT(j)  (256  + 64 * (j))
#define XB_XSUB(j)  (1280 + 64 * (j))
#define XB_XGEN(j)  (2304 + 64 * (j))
#define XB_TOP      3328
#define XB_TOPGEN   3392
#define XCD_BAR_WORDS 3456
#define XB_SPIN_CAP (1u << 18)
__device__ __forceinline__ unsigned xb_ld(unsigned* p)              { return __hip_atomic_load(p, __ATOMIC_RELAXED, __HIP_MEMORY_SCOPE_AGENT); }
__device__ __forceinline__ unsigned xb_add(unsigned* p, unsigned v) { return __hip_atomic_fetch_add(p, v, __ATOMIC_RELAXED, __HIP_MEMORY_SCOPE_AGENT); }
__device__ __forceinline__ unsigned xb_xcc_id() { return (unsigned)__builtin_amdgcn_s_getreg((3 << 11) | 20) & 0xFu; }
#define XB_SPIN(cond, bar) do { unsigned _sp = 0; while (cond) { __builtin_amdgcn_s_sleep(1); \
    if ((++_sp & 255u) == 0u) { if (xb_ld(&(bar)[XB_TMO])) break; if (_sp > XB_SPIN_CAP) { atomicAdd(&(bar)[XB_TMO], 1u); break; } } } } while (0)
struct XcdBarrier { unsigned* bar; unsigned x; volatile LAS unsigned* st; };
__device__ __forceinline__ XcdBarrier xcd_barrier_post(unsigned* bar, volatile LAS unsigned* st) {
    XcdBarrier b; b.bar = bar; b.x = xb_xcc_id(); b.st = st;
    if (threadIdx.x == 0) (void)xb_add(&bar[XB_XCNT(b.x)], 1u);
    return b;
}
__device__ __forceinline__ void xcd_barrier_complete(unsigned* bar, unsigned x, unsigned& nloc, unsigned& nx) {
    const unsigned G = gridDim.x * gridDim.y * gridDim.z;
    unsigned sum, cnt, mine, sp = 0u;
    for (;;) {
        sum = 0u; cnt = 0u; mine = 0u;
#pragma unroll
        for (unsigned j = 0; j < 16; ++j) { const unsigned c = xb_ld(&bar[XB_XCNT(j)]); sum += c; cnt += (c > 0u) ? 1u : 0u; mine = (j == x) ? c : mine; }
        if (sum == G) break;
        __builtin_amdgcn_s_sleep(1);
        if ((++sp & 255u) == 0u) { if (xb_ld(&bar[XB_TMO])) break; if (sp > XB_SPIN_CAP) { atomicAdd(&bar[XB_TMO], 1u); break; } }
    }
    nloc = mine > 0u ? mine : 1u; nx = cnt > 0u ? cnt : 1u;
}
__device__ __forceinline__ void xcd_barrier(const XcdBarrier& b) {
    asm volatile("s_waitcnt vmcnt(0)" ::: "memory");
    __syncthreads();
    if (threadIdx.x == 0) {
        unsigned* bar = b.bar;
        __builtin_amdgcn_s_waitcnt(0);
        unsigned nloc = b.st[0], nx = b.st[1];
        if (nloc == 0u) { xcd_barrier_complete(bar, b.x, nloc, nx); b.st[0] = nloc; b.st[1] = nx; }
        const unsigned old = xb_add(&bar[XB_XSUB(b.x)], 1u);
        const unsigned gen = old / nloc;
        if (old + 1u == (gen + 1u) * nloc) {
            __builtin_amdgcn_fence(__ATOMIC_RELEASE, "agent");
            asm volatile("s_waitcnt vmcnt(0)" ::: "memory");
            const unsigned og = xb_add(&bar[XB_TOP], 1u);
            const unsigned tg = og / nx;
            if (og + 1u == (tg + 1u) * nx) xb_add(&bar[XB_TOPGEN], 1u);
            else XB_SPIN(xb_ld(&bar[XB_TOPGEN]) == tg, bar);
            __builtin_amdgcn_fence(__ATOMIC_ACQUIRE, "agent");
            xb_add(&bar[XB_XGEN(b.x)], 1u);
            asm volatile("s_waitcnt vmcnt(0)" ::: "memory");
        } else {
            XB_SPIN(xb_ld(&bar[XB_XGEN(b.x)]) == gen, bar);
            __builtin_amdgcn_fence(__ATOMIC_ACQUIRE, "agent");
            asm volatile("s_waitcnt vmcnt(0)" ::: "memory");
        }
    }
    __syncthreads();
}

struct Unit { int pm, pn, e, mb, nrows; const char* a; const char* b0; const char* b1; };
__device__ __forceinline__ int lane_id() { int l; asm volatile("v_mbcnt_lo_u32_b32 %0, -1, 0\n\tv_mbcnt_hi_u32_b32 %0, -1, %0" : "=v"(l)); return l; }
__device__ __forceinline__ void glds16(const char* sbase, unsigned voff, unsigned lds_dst) {
    unsigned keep;
    asm volatile("s_mov_b32 %0, m0\n\ts_mov_b32 m0, %3\n\ts_nop 0\n\tglobal_load_lds_dwordx4 %1, %2\n\ts_mov_b32 m0, %0" : "=&s"(keep) : "v"(voff), "s"(sbase), "s"(lds_dst) : "memory");
}
template <class Epi, class Sched>
__device__ __forceinline__ void gemm_phase(LAS unsigned char* lds, const int wid  , const Sched& S, const Epi& E, const int K, const int ldb) {
    const int lane = lane_id(), tid = wid * 64 + lane, wr = wid >> 2, wc = wid & 3, fr = lane & 15, fq = lane >> 4;
    const int nt = K / BK;
    int stR[2], stC[2]; unsigned voffB[2];
#pragma unroll
    for (int i = 0; i < 2; ++i) { int R, C; stage_rc(tid * 16 + i * 8192, R, C); stR[i] = R; stC[i] = C; const int Rb = Epi::PERM ? ((R & ~31) + perm32(R & 31)) : R; voffB[i] = (unsigned)(Rb * ldb + C) * 2u; }
    const size_t kstep = (size_t)(BK * 2);
    const unsigned ldsw = (unsigned)(size_t)lds + (unsigned)wid * 1024u;
    const int aoff = lds_byte(wr * 64 + fr, fq * 8), boff = lds_byte(wc * 32 + fr, fq * 8);
#define PG8_SA(b, h) (((b) * 2 + (h)) * HTB)
#define PG8_SB(b, h) ((4 + (b) * 2 + (h)) * HTB)
#define PG8_STAGE(bufoff, gbase, voff) do { _Pragma("unroll") for (int _i = 0; _i < 2; ++_i) glds16((const char*)(gbase), (voff)[_i], ldsw + (unsigned)(bufoff) + (unsigned)_i * 8192u); } while (0)
#define PG8_LDA(dst, b, h) do { _Pragma("unroll") for (int m = 0; m < 4; ++m) _Pragma("unroll") for (int k = 0; k < 2; ++k) dst[m][k] = *(const LAS bf16x8*)(lds + PG8_SA(b, h) + aoff + m * 2048 + k * 1024); } while (0)
#define PG8_LDB(dst, b, h) do { _Pragma("unroll") for (int n = 0; n < 2; ++n) _Pragma("unroll") for (int k = 0; k < 2; ++k) dst[n][k] = *(const LAS bf16x8*)(lds + PG8_SB(b, h) + boff + n * 2048 + k * 1024); } while (0)
#define PG8_MMA(ai, bj, At, Bt) do { __builtin_amdgcn_s_setprio(1); _Pragma("unroll") for (int m = 0; m < 4; ++m) _Pragma("unroll") for (int n = 0; n < 2; ++n) _Pragma("unroll") for (int k = 0; k < 2; ++k) \
        acc[ai][bj][m][n] = __builtin_amdgcn_mfma_f32_16x16x32_bf16(Bt[n][k], At[m][k], acc[ai][bj][m][n], 0, 0, 0); __builtin_amdgcn_s_setprio(0); } while (0)
#define PG8_WAIT_V(n) asm volatile("s_waitcnt vmcnt(" #n ")" ::: "memory")
#define PG8_WAIT_L(n) asm volatile("s_waitcnt lgkmcnt(" #n ")" ::: "memory")
#define PG8_BAR __builtin_amdgcn_s_barrier()
#define PG8_SCHED __builtin_amdgcn_sched_barrier(0)
    Unit cur, nxt; int ui = 0;
    if (!S.next(0, cur)) return;
    unsigned vcur[2][2], vnxt[2][2];
    S.avoff(cur, stR, stC, vcur);
    f32x4 acc[2][2][4][2];
#pragma unroll
    for (int a = 0; a < 2; ++a)
#pragma unroll
        for (int b = 0; b < 2; ++b)
#pragma unroll
            for (int m = 0; m < 4; ++m)
#pragma unroll
                for (int n = 0; n < 2; ++n) acc[a][b][m][n] = (f32x4){0.f, 0.f, 0.f, 0.f};
    bf16x8 At[4][2], B0[2][2], B1[2][2];
    PG8_STAGE(PG8_SB(0, 0), cur.b0, voffB); PG8_STAGE(PG8_SB(0, 1), cur.b1, voffB); PG8_STAGE(PG8_SA(0, 0), cur.a, vcur[0]); PG8_STAGE(PG8_SA(0, 1), cur.a, vcur[1]);
    if (wr == 1) PG8_BAR;
    PG8_WAIT_V(2); PG8_BAR;
    PG8_STAGE(PG8_SB(1, 0), cur.b0 + kstep, voffB); PG8_STAGE(PG8_SA(1, 0), cur.a + kstep, vcur[0]); PG8_STAGE(PG8_SB(1, 1), cur.b1 + kstep, voffB);
    PG8_WAIT_V(6); PG8_BAR;
    for (;;) {
        const bool has_next = S.next(ui + 1, nxt);
        if (has_next) S.avoff(nxt, stR, stC, vnxt);
        else {
#pragma unroll
            for (int h = 0; h < 2; ++h)
#pragma unroll
                for (int i = 0; i < 2; ++i) vnxt[h][i] = vcur[h][i];
        }
        const char* nA = has_next ? nxt.a : cur.a; const char* nB0 = has_next ? nxt.b0 : cur.b0; const char* nB1 = has_next ? nxt.b1 : cur.b1;
        for (int t = 0; t < nt; t += 2) {
            const bool last = (t == nt - 2);
            const char* a1 = cur.a + (size_t)(t + 1) * kstep;
            const char* a2 = last ? nA : cur.a + (size_t)(t + 2) * kstep;
            const char* b20 = last ? nB0 : cur.b0 + (size_t)(t + 2) * kstep; const char* b21 = last ? nB1 : cur.b1 + (size_t)(t + 2) * kstep;
            const char* a3 = a2 + kstep; const char* b30 = b20 + kstep; const char* b31 = b21 + kstep;
            unsigned v2[2][2];
#pragma unroll
            for (int h = 0; h < 2; ++h)
#pragma unroll
                for (int i = 0; i < 2; ++i) v2[h][i] = last ? vnxt[h][i] : vcur[h][i];
            PG8_LDB(B0, 0, 0); PG8_LDB(B1, 0, 1); PG8_SCHED; PG8_LDA(At, 0, 0); PG8_STAGE(PG8_SA(1, 1), a1, vcur[1]);
            PG8_WAIT_V(8); PG8_WAIT_L(0); PG8_BAR; PG8_MMA(0, 0, At, B0); PG8_MMA(0, 1, At, B1); PG8_BAR; PG8_SCHED;
            PG8_LDA(At, 0, 1); PG8_STAGE(PG8_SB(0, 0), b20, voffB); PG8_STAGE(PG8_SB(0, 1), b21, voffB); PG8_STAGE(PG8_SA(0, 0), a2, v2[0]);
            PG8_WAIT_V(8); PG8_WAIT_L(0); PG8_BAR; PG8_MMA(1, 0, At, B0); PG8_MMA(1, 1, At, B1); PG8_BAR; PG8_SCHED;
            PG8_LDB(B0, 1, 0); PG8_LDB(B1, 1, 1); PG8_SCHED; PG8_LDA(At, 1, 0); PG8_STAGE(PG8_SA(0, 1), a2, v2[1]);
            PG8_WAIT_V(8); PG8_WAIT_L(0); PG8_BAR; PG8_MMA(0, 0, At, B0); PG8_MMA(0, 1, At, B1); PG8_BAR; PG8_SCHED;
            PG8_LDA(At, 1, 1); PG8_STAGE(PG8_SB(1, 0), b30, voffB); PG8_STAGE(PG8_SB(1, 1), b31, voffB); PG8_STAGE(PG8_SA(1, 0), a3, v2[0]);
            PG8_WAIT_V(8); PG8_WAIT_L(0); PG8_BAR; PG8_MMA(1, 0, At, B0); PG8_MMA(1, 1, At, B1); PG8_BAR; PG8_SCHED;
        }
        if (wr == 0) PG8_BAR;
        E(acc, cur, wr, wc, fr, fq);
        if (!has_next) break;
#pragma unroll
        for (int a = 0; a < 2; ++a)
#pragma unroll
            for (int b = 0; b < 2; ++b)
#pragma unroll
                for (int m = 0; m < 4; ++m)
#pragma unroll
                    for (int n = 0; n < 2; ++n) acc[a][b][m][n] = (f32x4){0.f, 0.f, 0.f, 0.f};
        cur = nxt;
#pragma unroll
        for (int h = 0; h < 2; ++h)
#pragma unroll
            for (int i = 0; i < 2; ++i) vcur[h][i] = vnxt[h][i];
        ++ui;
        if (wr == 1) PG8_BAR;
    }
    PG8_WAIT_V(0);
    PG8_BAR;
#undef PG8_SA
#undef PG8_SB
#undef PG8_STAGE
#undef PG8_LDA
#undef PG8_LDB
#undef PG8_MMA
#undef PG8_WAIT_V
#undef PG8_WAIT_L
#undef PG8_BAR
#undef PG8_SCHED
}

__device__ __forceinline__ bool static_tile(int i, int G, int c, int nM, int nN, int& pm, int& pn) {
    const int nwg = nM * nN; const long L = (long)i * G + c; if (L >= nwg) return false;
    int wgid = (int)L; { const int q = nwg / NXCD, r = nwg % NXCD, xcd = wgid % NXCD, off = wgid / NXCD; wgid = (xcd < r ? xcd * (q + 1) : r * (q + 1) + (xcd - r) * q) + off; }
    const int nig = WGM * nN, gid = wgid / nig, fm = gid * WGM, gsz = (nM - fm) < WGM ? (nM - fm) : WGM;
    pm = fm + ((wgid % nig) % gsz); pn = (wgid % nig) / gsz; return true;
}
struct SchedTile {
    const char* A; const char* B; int lda, ldb, nM, nN, G, c; size_t a_pn_stride, b_pn_stride; int i0, n;
    __device__ __forceinline__ bool next(int i, Unit& u) const {
        if (i >= n || !static_tile(i + i0, G, c, nM, nN, u.pm, u.pn)) return false;
        u.e = 0; u.mb = 0; u.nrows = 256;
        u.a = A + (size_t)u.pm * 256 * lda * 2 + (size_t)u.pn * a_pn_stride; u.b0 = B + (size_t)u.pn * b_pn_stride; u.b1 = u.b0 + (size_t)128 * ldb * 2; return true;
    }
    __device__ __forceinline__ void avoff(const Unit&, const int (&R)[2], const int (&C)[2], unsigned (&v)[2][2]) const {
#pragma unroll
        for (int h = 0; h < 2; ++h)
#pragma unroll
            for (int i = 0; i < 2; ++i) v[h][i] = (unsigned)((h * 128 + R[i]) * lda + C[i]) * 2u;
    }
};
struct SchedSeg {
    const char* A0; const char* A1; const char* B0; const char* B1; int G, c, i0, n;
    __device__ __forceinline__ bool next(int ii, Unit& u) const {
        const int i = ii + i0; if (ii >= n || i > 1) return false;
        if (!static_tile(0, G, c, NTOK / 256, DM / 256, u.pm, u.pn)) return false;
        u.e = i; u.mb = 0; u.nrows = 256;
        u.a = (i ? A1 : A0) + (size_t)u.pm * 256 * 1024 * 2; u.b0 = (i ? B1 : B0) + (size_t)u.pn * 256 * 1024 * 2; u.b1 = u.b0 + (size_t)128 * 1024 * 2; return true;
    }
    __device__ __forceinline__ void avoff(const Unit&, const int (&R)[2], const int (&C)[2], unsigned (&v)[2][2]) const {
#pragma unroll
        for (int h = 0; h < 2; ++h)
#pragma unroll
            for (int i = 0; i < 2; ++i) v[h][i] = (unsigned)((h * 128 + R[i]) * 1024 + C[i]) * 2u;
    }
};
struct SchedMoe {
    const char* A; const char* B; const int* list; const LAS int* l_cnt; const LAS int* l_ub; const LAS int* l_roff; int G, c, ntl  ; bool gu; int i0, n;
    __device__ __forceinline__ bool next(int ii, Unit& u) const {
        if (ii >= n) return false;
        const int id = (ii + i0) * G + c; if (id >= __builtin_amdgcn_readfirstlane(l_ub[NE])) return false;
        int e = 0;
#pragma unroll 1
        for (int j = 1; j < NE; ++j) e += (id >= __builtin_amdgcn_readfirstlane(l_ub[j])) ? 1 : 0;
        const int loc = id - __builtin_amdgcn_readfirstlane(l_ub[e]), cnt = __builtin_amdgcn_readfirstlane(l_cnt[e]), nmb = (cnt + 255) >> 8, mb = loc % nmb, tn = loc / nmb;
        u.e = e; u.mb = mb; u.pn = tn; u.pm = (__builtin_amdgcn_readfirstlane(l_roff[e]) >> 8) + mb; u.nrows = (cnt - mb * 256) < 256 ? (cnt - mb * 256) : 256;
        if (gu) { u.a = A; u.b0 = B + ((size_t)e * 4096 + (size_t)tn * 128) * DM * 2; u.b1 = u.b0 + (size_t)2048 * DM * 2; }
        else    { u.a = A + (size_t)u.pm * 256 * DM * 2; u.b0 = B + ((size_t)e * 2048 + (size_t)tn * 256) * DM * 2; u.b1 = u.b0 + (size_t)128 * DM * 2; }
        return true;
    }
    __device__ __forceinline__ void avoff(const Unit& u, const int (&R)[2], const int (&C)[2], unsigned (&v)[2][2]) const {
#pragma unroll
        for (int h = 0; h < 2; ++h)
#pragma unroll
            for (int i = 0; i < 2; ++i) {
                const int r = h * 128 + R[i];
                if (gu) { const int idx = (r < u.nrows) ? (u.mb * 256 + r) : (u.mb * 256); const int tok = list[u.e * LCAP + idx] >> 2; v[h][i] = (unsigned)(tok * DM + C[i]) * 2u; }
                else v[h][i] = (unsigned)(r * DM + C[i]) * 2u;
            }
    }
};

#define EPI_LOOP_AM _Pragma("unroll") for (int ai = 0; ai < 2; ++ai) _Pragma("unroll") for (int m = 0; m < 4; ++m)
struct EpiProj {
    static constexpr bool PERM = true; bf16_t* O;
    __device__ __forceinline__ void operator()(const f32x4 (&acc)[2][2][4][2], const Unit& u, int wr, int wc, int fr, int fq) const {
        const int row0 = u.pm * BM + wr * 64 + fr, col0 = u.pn * BM + wc * 32 + 8 * fq; const bool sg = u.pn >= 16;
        EPI_LOOP_AM { bf16_t* rowp = O + (size_t)(row0 + ai * HALF + m * 16) * NIN + col0;
#pragma unroll
            for (int bj = 0; bj < 2; ++bj) { f32x4 v0 = acc[ai][bj][m][0], v1 = acc[ai][bj][m][1]; if (sg) { v0 = sigm4(v0); v1 = sigm4(v1); }
                u32x4 w; w.x = cvt_pk_bf16(v0[0], v0[1]); w.y = cvt_pk_bf16(v0[2], v0[3]); w.z = cvt_pk_bf16(v1[0], v1[1]); w.w = cvt_pk_bf16(v1[2], v1[3]); *(u32x4*)(rowp + bj * HALF) = w; } }
    }
};
struct EpiBf16Scale {
    static constexpr bool PERM = true; bf16_t* O; int ldc; const float* scale;
    __device__ __forceinline__ void operator()(const f32x4 (&acc)[2][2][4][2], const Unit& u, int wr, int wc, int fr, int fq) const {
        const int row0 = u.pm * BM + wr * 64 + fr, col0 = u.pn * BM + wc * 32 + 8 * fq;
        f32x4 sc[2][2];
#pragma unroll
        for (int bj = 0; bj < 2; ++bj)
#pragma unroll
            for (int n = 0; n < 2; ++n) sc[bj][n] = scale ? *(const f32x4*)(scale + col0 + bj * HALF + 4 * n) : (f32x4){1.f, 1.f, 1.f, 1.f};
        EPI_LOOP_AM { bf16_t* rowp = O + (size_t)(row0 + ai * HALF + m * 16) * ldc + col0;
#pragma unroll
            for (int bj = 0; bj < 2; ++bj) { const f32x4 v0 = acc[ai][bj][m][0] * sc[bj][0], v1 = acc[ai][bj][m][1] * sc[bj][1];
                u32x4 w; w.x = cvt_pk_bf16(v0[0], v0[1]); w.y = cvt_pk_bf16(v0[2], v0[3]); w.z = cvt_pk_bf16(v1[0], v1[1]); w.w = cvt_pk_bf16(v1[2], v1[3]); *(u32x4*)(rowp + bj * HALF) = w; } }
    }
};
struct EpiBranch {
    static constexpr bool PERM = true; const bf16_t* PROJ; float* M1; bf16_t* MB;
    __device__ __forceinline__ void operator()(const f32x4 (&acc)[2][2][4][2], const Unit& u, int wr, int wc, int fr, int fq) const {
        const int row0 = u.pm * BM + wr * 64 + fr, col0 = u.pn * BM + wc * 32 + 8 * fq; const int seg = u.e;
        EPI_LOOP_AM { const size_t row = (size_t)(row0 + ai * HALF + m * 16);
#pragma unroll
            for (int bj = 0; bj < 2; ++bj) { const int col = col0 + bj * HALF;
                const u32x4 gw = *(const u32x4*)(PROJ + row * NIN + 4096 + seg * 2048 + col);
                const f32x4 g0 = (f32x4){bf_lo(gw.x), bf_hi(gw.x), bf_lo(gw.y), bf_hi(gw.y)}, g1 = (f32x4){bf_lo(gw.z), bf_hi(gw.z), bf_lo(gw.w), bf_hi(gw.w)};
                f32x4 v0 = acc[ai][bj][m][0] * g0, v1 = acc[ai][bj][m][1] * g1; float* mp = M1 + row * DM + col;
                if (seg == 0) { *(f32x4*)mp = v0; *(f32x4*)(mp + 4) = v1; }
                else { v0 += *(const f32x4*)mp; v1 += *(const f32x4*)(mp + 4);
                    u32x4 w; w.x = cvt_pk_bf16(v0[0], v0[1]); w.y = cvt_pk_bf16(v0[2], v0[3]); w.z = cvt_pk_bf16(v1[0], v1[1]); w.w = cvt_pk_bf16(v1[2], v1[3]); *(u32x4*)(MB + row * DM + col) = w; } } }
    }
};
struct EpiWo {
    static constexpr bool PERM = false; const float* X; float* O;
    __device__ __forceinline__ void operator()(const f32x4 (&acc)[2][2][4][2], const Unit& u, int wr, int wc, int fr, int fq) const {
        const int row0 = u.pm * BM + wr * 64 + fr, col0 = u.pn * BM + wc * 32 + 4 * fq;
        EPI_LOOP_AM { const size_t off = (size_t)(row0 + ai * HALF + m * 16) * DM + col0;
#pragma unroll
            for (int bj = 0; bj < 2; ++bj)
#pragma unroll
                for (int n = 0; n < 2; ++n) { const f32x4 xv = *(const f32x4*)(X + off + bj * HALF + n * 16); *(f32x4*)(O + off + bj * HALF + n * 16) = xv * ALPHA + acc[ai][bj][m][n]; } }
    }
};
struct EpiGU {
    static constexpr bool PERM = true; bf16_t* O; const float* bias;
    __device__ __forceinline__ void operator()(const f32x4 (&acc)[2][2][4][2], const Unit& u, int wr, int wc, int fr, int fq) const {
        const int row0 = u.pm * BM + wr * 64 + fr, col0 = u.pn * 128 + wc * 32 + 8 * fq;
        f32x4 bg[2], bu[2];
#pragma unroll
        for (int n = 0; n < 2; ++n) { bg[n] = *(const f32x4*)(bias + (size_t)u.e * 4096 + col0 + 4 * n); bu[n] = *(const f32x4*)(bias + (size_t)u.e * 4096 + 2048 + col0 + 4 * n); }
        EPI_LOOP_AM { f32x4 o[2];
#pragma unroll
            for (int n = 0; n < 2; ++n) { const f32x4 g = acc[ai][0][m][n] + bg[n], up = acc[ai][1][m][n] + bu[n];
#pragma unroll
                for (int j = 0; j < 4; ++j) { const float gg = fminf(g[j], 7.0f), uu = fminf(fmaxf(up[j], -7.0f), 7.0f); o[n][j] = (uu + 1.0f) * (gg * sigm(1.702f * gg)); } }
            u32x4 w; w.x = cvt_pk_bf16(o[0][0], o[0][1]); w.y = cvt_pk_bf16(o[0][2], o[0][3]); w.z = cvt_pk_bf16(o[1][0], o[1][1]); w.w = cvt_pk_bf16(o[1][2], o[1][3]);
            *(u32x4*)(O + (size_t)(row0 + ai * HALF + m * 16) * DM + col0) = w; }
    }
};
struct EpiDown {
    static constexpr bool PERM = true; bf16_t* O; const float* bias; const int* list;
    __device__ __forceinline__ void operator()(const f32x4 (&acc)[2][2][4][2], const Unit& u, int wr, int wc, int fr, int fq) const {
        const int col0 = u.pn * BM + wc * 32 + 8 * fq;
        f32x4 bv[2][2];
#pragma unroll
        for (int bj = 0; bj < 2; ++bj)
#pragma unroll
            for (int n = 0; n < 2; ++n) bv[bj][n] = *(const f32x4*)(bias + (size_t)u.e * DM + col0 + bj * HALF + 4 * n);
        EPI_LOOP_AM { const int r = ai * HALF + wr * 64 + m * 16 + fr;
            if (r < u.nrows) { const int dst = list[u.e * LCAP + u.mb * 256 + r]; bf16_t* rowp = O + (size_t)dst * DM + col0;
#pragma unroll
                for (int bj = 0; bj < 2; ++bj) { const f32x4 v0 = acc[ai][bj][m][0] + bv[bj][0], v1 = acc[ai][bj][m][1] + bv[bj][1];
                    u32x4 w; w.x = cvt_pk_bf16(v0[0], v0[1]); w.y = cvt_pk_bf16(v0[2], v0[3]); w.z = cvt_pk_bf16(v1[0], v1[1]); w.w = cvt_pk_bf16(v1[2], v1[3]); *(u32x4*)(rowp + bj * HALF) = w; } } }
    }
};
struct EpiPg {
    static constexpr bool PERM = false; const float* H2; const bf16_t* PLEB; const float* bias; float* O;
    __device__ __forceinline__ void operator()(const f32x4 (&acc)[2][2][4][2], const Unit& u, int wr, int wc, int fr, int fq) const {
        const int row0 = u.pm * BM + wr * 64 + fr, col0 = u.pn * BM + wc * 32 + 4 * fq;
        f32x4 bv[2][2];
#pragma unroll
        for (int bj = 0; bj < 2; ++bj)
#pragma unroll
            for (int n = 0; n < 2; ++n) bv[bj][n] = *(const f32x4*)(bias + col0 + bj * HALF + n * 16);
        EPI_LOOP_AM { const size_t off = (size_t)(row0 + ai * HALF + m * 16) * DM + col0;
#pragma unroll
            for (int bj = 0; bj < 2; ++bj)
#pragma unroll
                for (int n = 0; n < 2; ++n) { const size_t o = off + bj * HALF + n * 16; const f32x4 hv = *(const f32x4*)(H2 + o); const u32x2 pw = *(const u32x2*)(PLEB + o);
                    const f32x4 pv = (f32x4){bf_lo(pw.x), bf_hi(pw.x), bf_lo(pw.y), bf_hi(pw.y)};
                    *(f32x4*)(O + o) = hv * ALPHA + sigm4(acc[ai][bj][m][n] + bv[bj][n]) * pv; } }
    }
};
struct Args { const float* in[24]; float* out; unsigned char* ws; int ph_lo, ph_hi; };
struct Frame {
    LAS unsigned char* lds; volatile LAS int* lctl; gu32* ctl;
    int wave, vcu, G;
    const Args* a; float* out; unsigned char* ws;
};
#define FIN(i) (F.a->in[i])
#define LDS_WAIT() asm volatile("s_waitcnt lgkmcnt(0)" ::: "memory")
__device__ __forceinline__ float wave_sum(float v) {
#pragma unroll
    for (int o = 1; o < 64; o <<= 1) v += __shfl_xor(v, o);
    return v;
}
__device__ __forceinline__ unsigned pk2(float lo, float hi) { return cvt_pk_bf16(lo, hi); }

__device__ __forceinline__ void p0_item(const float* W, int K, int N, bf16_t* WT, LAS unsigned char* scr, int item, int lane) {
    const int nblk = N >> 6, kb = item / nblk, nb = item - kb * nblk, k0 = kb * 64, n0 = nb * 64, nc = lane & 15, q = lane >> 4;
    f32x4 v[16];
#pragma unroll
    for (int i = 0; i < 16; ++i) v[i] = *(const f32x4*)(W + (size_t)(k0 + 16 * q + i) * N + n0 + 4 * nc);
#pragma unroll
    for (int j = 0; j < 4; ++j) {
        u32x4 w0, w1;
        w0.x = pk2(v[0][j], v[1][j]); w0.y = pk2(v[2][j], v[3][j]); w0.z = pk2(v[4][j], v[5][j]); w0.w = pk2(v[6][j], v[7][j]);
        w1.x = pk2(v[8][j], v[9][j]); w1.y = pk2(v[10][j], v[11][j]); w1.z = pk2(v[12][j], v[13][j]); w1.w = pk2(v[14][j], v[15][j]);
        LAS unsigned char* p = scr + (4 * nc + j) * 144 + 32 * q;
        *(LAS u32x4*)p = w0; *(LAS u32x4*)(p + 16) = w1;
    }
    LDS_WAIT(); asm volatile("" ::: "memory");
#pragma unroll
    for (int jj = 0; jj < 8; ++jj) { const int n = (lane >> 3) + 8 * jj, c = lane & 7; const u32x4 o = *(const LAS u32x4*)(scr + n * 144 + c * 16);
        *(u32x4*)(WT + (size_t)(n0 + n) * K + k0 + 8 * c) = o; }
    LDS_WAIT(); asm volatile("" ::: "memory");
}
__device__ __forceinline__ void conv_moe(Frame& F, int lo, int hi) {
    const int lane = lane_id();
    LAS unsigned char* scr = F.lds + F.wave * 16384;
    unsigned char* ws = F.ws;
    constexpr int I_SQ = 32 * 32, I_GU = 32 * 64;
    for (int it = lo + F.wave; it < hi; it += NWAVES) {
        if (it < 32 * I_GU) { const int e = it / I_GU; p0_item(FIN(13) + (size_t)e * DM * 4096, DM, 4096, (bf16_t*)(ws + WS_WGU) + (size_t)e * 4096 * DM, scr, it - e * I_GU, lane); }
        else { const int r = it - 32 * I_GU, e = r / I_SQ; p0_item(FIN(15) + (size_t)e * DM * DM, DM, DM, (bf16_t*)(ws + WS_WDN) + (size_t)e * DM * DM, scr, r - e * I_SQ, lane); }
    }
    __syncthreads();
}
__device__ __forceinline__ void p0_prologue(Frame& F) {
    const int lane = lane_id(), tid = F.wave * 64 + lane;
    LAS unsigned char* scr = F.lds + F.wave * 16384;
    const int gw = F.vcu * NWAVES + F.wave, NGW = F.G * NWAVES;
    unsigned char* ws = F.ws;
    constexpr int I_IN = 32 * 128, I_POOL = 16, I_BR = 16 * 32, I_SQ = 32 * 32, I_PLE = 4 * 32;
    constexpr int NITEMS = I_IN + 4 * I_POOL + 2 * I_BR + 2 * I_SQ + I_PLE;
    for (int it = gw; it < NITEMS; it += NGW) {
        int r = it;
        if (r < I_IN) { p0_item(FIN(2), DM, NIN, (bf16_t*)(ws + WS_WIN), scr, r, lane); continue; } r -= I_IN;
        if (r < 4 * I_POOL) { const int g = r / I_POOL; p0_item(FIN(3) + g * 65536, 256, 256, (bf16_t*)(ws + WS_WPOOL) + g * 65536, scr, r - g * I_POOL, lane); continue; } r -= 4 * I_POOL;
        if (r < I_BR) { p0_item(FIN(6), 1024, DM, (bf16_t*)(ws + WS_WBRA), scr, r, lane); continue; } r -= I_BR;
        if (r < I_BR) { p0_item(FIN(7), 1024, DM, (bf16_t*)(ws + WS_WBRB), scr, r, lane); continue; } r -= I_BR;
        if (r < I_SQ) { p0_item(FIN(8), DM, DM, (bf16_t*)(ws + WS_WO), scr, r, lane); continue; } r -= I_SQ;
        if (r < I_SQ) { p0_item(FIN(19), DM, DM, (bf16_t*)(ws + WS_WPG), scr, r, lane); continue; } r -= I_SQ;
        p0_item(FIN(21), PLE, DM, (bf16_t*)(ws + WS_WPLE), scr, r, lane);
    }
    const size_t gt = (size_t)F.vcu * 512 + tid, NT = (size_t)F.G * 512;
    for (size_t i = gt; i < (size_t)NTOK * DM / 8; i += NT) { const f32x4 a = *(const f32x4*)(FIN(0) + i * 8), b = *(const f32x4*)(FIN(0) + i * 8 + 4);
        u32x4 w; w.x = pk2(a[0], a[1]); w.y = pk2(a[2], a[3]); w.z = pk2(b[0], b[1]); w.w = pk2(b[2], b[3]); *(u32x4*)((bf16_t*)(ws + WS_XB) + i * 8) = w; }
    for (size_t i = gt; i < (size_t)NTOK * PLE / 8; i += NT) { const f32x4 a = *(const f32x4*)(FIN(1) + i * 8), b = *(const f32x4*)(FIN(1) + i * 8 + 4);
        u32x4 w; w.x = pk2(a[0], a[1]); w.y = pk2(a[2], a[3]); w.z = pk2(b[0], b[1]); w.w = pk2(b[2], b[3]); *(u32x4*)((bf16_t*)(ws + WS_PB) + i * 8) = w; }
    for (size_t i = gt; i < (size_t)NE * DM; i += NT) { const int e = (int)(i >> 11), c = (int)(i & 2047); ((float*)(ws + WS_WRT))[i] = FIN(11)[c * NE + e]; }
}

__device__ __forceinline__ void unpack8(const u32x4 w, float (&f)[8]) { f[0] = bf_lo(w.x); f[1] = bf_hi(w.x); f[2] = bf_lo(w.y); f[3] = bf_hi(w.y); f[4] = bf_lo(w.z); f[5] = bf_hi(w.z); f[6] = bf_lo(w.w); f[7] = bf_hi(w.w); }
__device__ __forceinline__ u32x4 pack8(const float (&f)[8]) { u32x4 w; w.x = pk2(f[0], f[1]); w.y = pk2(f[2], f[3]); w.z = pk2(f[4], f[5]); w.w = pk2(f[6], f[7]); return w; }
__device__ __forceinline__ void p2_poolconv(Frame& F) {
    const int lane = lane_id(), tid = F.wave * 64 + lane;
    const bf16_t* PROJ = (const bf16_t*)(F.ws + WS_PROJ); bf16_t* POOLED = (bf16_t*)(F.ws + WS_POOLED); bf16_t* BCONV = (bf16_t*)(F.ws + WS_BCONV); const float* conv_w = FIN(5);
    const int gt = F.vcu * 512 + tid, NT = F.G * 512;
    for (int idx = gt; idx < NTOK * 128; idx += NT) {
        const int t = idx >> 7, ch = (idx & 127) * 8, tl = t & (SEQL - 1), g = ch >> 8, w = 2 << g, n = (tl + 1 < w) ? tl + 1 : w;
        float u[8], s[8], x[8];
        u32x4 wv[16];
#pragma unroll
        for (int j = 0; j < 16; ++j) wv[j] = *(const u32x4*)(PROJ + (size_t)(t - (j < n ? j : 0)) * NIN + ch);
        unpack8(wv[0], u);
#pragma unroll
        for (int q = 0; q < 8; ++q) s[q] = u[q];
#pragma unroll
        for (int j = 1; j < 16; ++j) { unpack8(wv[j], x); const float mk = (j < n) ? 1.0f : 0.0f;
#pragma unroll
            for (int q = 0; q < 8; ++q) s[q] = fmaf(mk, x[q], s[q]); }
        const float inv = 1.0f / (float)n;
#pragma unroll
        for (int q = 0; q < 8; ++q) s[q] = s[q] * inv - u[q];
        *(u32x4*)(POOLED + (size_t)t * 1024 + ch) = pack8(s);
        float acc[8], cc[8], cv[8];
#pragma unroll
        for (int q = 0; q < 8; ++q) acc[q] = 0.f;
#pragma unroll
        for (int j = 0; j < 3; ++j) { const int d = 2 - j;
            if (tl - d >= 0) { unpack8(*(const u32x4*)(PROJ + (size_t)(t - d) * NIN + 2048 + ch), cc); unpack8(*(const u32x4*)(PROJ + (size_t)(t - d) * NIN + 3072 + ch), cv);
                const f32x4 w0 = *(const f32x4*)(conv_w + j * 1024 + ch), w1 = *(const f32x4*)(conv_w + j * 1024 + ch + 4);
#pragma unroll
                for (int q = 0; q < 4; ++q) { acc[q] += w0[q] * cc[q] * cv[q]; acc[q + 4] += w1[q] * cc[q + 4] * cv[q + 4]; } } }
        unpack8(*(const u32x4*)(PROJ + (size_t)t * NIN + 1024 + ch), x);
#pragma unroll
        for (int q = 0; q < 8; ++q) acc[q] *= x[q];
        *(u32x4*)(BCONV + (size_t)t * 1024 + ch) = pack8(acc);
    }
}

__device__ __forceinline__ void p6_ln1_router(Frame& F) {
    const float* PRE1 = (const float*)(F.ws + WS_PRE1); float* X1 = (float*)(F.ws + WS_X1); bf16_t* X1B = (bf16_t*)(F.ws + WS_X1B);
    const float* WRT = (const float*)(F.ws + WS_WRT); const float* g1 = FIN(9); const float* b1 = FIN(10); const float* b_router = FIN(12);
    int* cnt = (int*)(F.ctl + CW_CNT); int* list = (int*)(F.ws + WS_LIST); int* tok_e = (int*)(F.ws + WS_TOK); float* tok_gate = (float*)(F.ws + WS_TOK + 128 * 1024);
    const int lane = lane_id(), tid = F.wave * 64 + lane, row_base = F.vcu * 32 + F.wave * 4;
    float xr[4][32];
#pragma unroll
    for (int r = 0; r < 4; ++r) {
        const size_t ro = (size_t)(row_base + r) * DM; float s = 0.f;
#pragma unroll
        for (int j = 0; j < 8; ++j) { const f32x4 v = *(const f32x4*)(PRE1 + ro + 256 * j + 4 * lane); xr[r][4 * j] = v[0]; xr[r][4 * j + 1] = v[1]; xr[r][4 * j + 2] = v[2]; xr[r][4 * j + 3] = v[3]; s += (v[0] + v[1]) + (v[2] + v[3]); }
        const float mean = wave_sum(s) * (1.0f / DM); float q = 0.f;
#pragma unroll
        for (int k = 0; k < 32; ++k) { xr[r][k] -= mean; q += xr[r][k] * xr[r][k]; }
        const float rstd = rsqrtf(wave_sum(q) * (1.0f / DM) + LN_EPS);
#pragma unroll
        for (int j = 0; j < 8; ++j) { const f32x4 gv = *(const f32x4*)(g1 + 256 * j + 4 * lane), bv = *(const f32x4*)(b1 + 256 * j + 4 * lane); f32x4 y;
#pragma unroll
            for (int k = 0; k < 4; ++k) { y[k] = xr[r][4 * j + k] * rstd * gv[k] + bv[k]; xr[r][4 * j + k] = y[k]; }
            *(f32x4*)(X1 + ro + 256 * j + 4 * lane) = y; u32x2 w; w.x = pk2(y[0], y[1]); w.y = pk2(y[2], y[3]); *(u32x2*)(X1B + ro + 256 * j + 4 * lane) = w; }
    }
    float lgt[4] = {0.f, 0.f, 0.f, 0.f};
#pragma unroll 1
    for (int pass = 0; pass < 2; ++pass) {
        __syncthreads();
        for (int i = tid; i < 16 * DM / 4; i += 512) *(LAS f32x4*)(F.lds + (size_t)i * 16) = *(const f32x4*)(WRT + (size_t)pass * 16 * DM + (size_t)i * 4);
        __syncthreads();
#pragma unroll 1
        for (int e = 0; e < 16; ++e) {
            float a0 = 0.f, a1 = 0.f, a2 = 0.f, a3 = 0.f;
#pragma unroll
            for (int j = 0; j < 8; ++j) { const f32x4 w = *(const LAS f32x4*)(F.lds + ((size_t)e * DM + 256 * j + 4 * lane) * 4);
#pragma unroll
                for (int k = 0; k < 4; ++k) { a0 = fmaf(xr[0][4 * j + k], w[k], a0); a1 = fmaf(xr[1][4 * j + k], w[k], a1); a2 = fmaf(xr[2][4 * j + k], w[k], a2); a3 = fmaf(xr[3][4 * j + k], w[k], a3); } }
            a0 = wave_sum(a0); a1 = wave_sum(a1); a2 = wave_sum(a2); a3 = wave_sum(a3);
            if (lane == pass * 16 + e) { lgt[0] = a0; lgt[1] = a1; lgt[2] = a2; lgt[3] = a3; }
        }
    }
    const float br = (lane < 32) ? b_router[lane & 31] : 0.f;
#pragma unroll
    for (int r = 0; r < 4; ++r) {
        float val = (lane < 32) ? lgt[r] + br : -3.0e38f; float tv[4]; int te[4];
#pragma unroll
        for (int k = 0; k < 4; ++k) { float bv = val; int bi = lane;
#pragma unroll
            for (int o = 32; o >= 1; o >>= 1) { const float ov = __shfl_xor(bv, o); const int oi = __shfl_xor(bi, o); if (ov > bv || (ov == bv && oi < bi)) { bv = ov; bi = oi; } }
            tv[k] = bv; te[k] = bi; if (lane == bi) val = -3.0e38f; }
        const float e1 = __expf(tv[1] - tv[0]), e2 = __expf(tv[2] - tv[0]), e3 = __expf(tv[3] - tv[0]); const float inv = 1.0f / (1.0f + e1 + e2 + e3);
        if (lane < 4) { const int ek = lane == 0 ? te[0] : lane == 1 ? te[1] : lane == 2 ? te[2] : te[3]; const float gk = (lane == 0 ? 1.0f : lane == 1 ? e1 : lane == 2 ? e2 : e3) * inv;
            const int t = row_base + r; const int rank = atomicAdd(&cnt[ek], 1); list[ek * LCAP + rank] = t * 4 + lane; tok_e[t * 4 + lane] = ek; tok_gate[t * 4 + lane] = gk; }
    }
}

template <int MODE  >
__device__ __forceinline__ void row_ln(Frame& F) {
    const float* src = MODE == 0 ? (const float*)(F.ws + WS_X1) : F.out; float* dst = MODE == 0 ? (float*)(F.ws + WS_H2) : F.out; bf16_t* dstb = (bf16_t*)(F.ws + WS_H2B);
    const bf16_t* Y = (const bf16_t*)(F.ws + WS_Y); const float* tok_gate = (const float*)(F.ws + WS_TOK + 128 * 1024);
    const float* g = MODE == 0 ? FIN(17) : FIN(22); const float* b = MODE == 0 ? FIN(18) : FIN(23);
    const int lane = lane_id(), gw = F.vcu * NWAVES + F.wave, NGW = F.G * NWAVES;
    for (int t = gw; t < NTOK; t += NGW) {
        const size_t ro = (size_t)t * DM; float v[32];
#pragma unroll
        for (int j = 0; j < 4; ++j) { const f32x4 a = *(const f32x4*)(src + ro + 512 * j + 8 * lane), c = *(const f32x4*)(src + ro + 512 * j + 8 * lane + 4);
#pragma unroll
            for (int k = 0; k < 4; ++k) { v[8 * j + k] = a[k]; v[8 * j + 4 + k] = c[k]; } }
        if (MODE == 0) {
            const f32x4 gt = *(const f32x4*)(tok_gate + t * 4);
#pragma unroll
            for (int k = 0; k < 32; ++k) v[k] *= ALPHA;
#pragma unroll
            for (int kk = 0; kk < 4; ++kk) {
#pragma unroll
                for (int j = 0; j < 4; ++j) { float y[8]; unpack8(*(const u32x4*)(Y + ((size_t)t * 4 + kk) * DM + 512 * j + 8 * lane), y);
#pragma unroll
                    for (int k = 0; k < 8; ++k) v[8 * j + k] = fmaf(gt[kk], y[k], v[8 * j + k]); } }
        }
        float s = 0.f;
#pragma unroll
        for (int k = 0; k < 32; ++k) s += v[k];
        const float mean = wave_sum(s) * (1.0f / DM); float q = 0.f;
#pragma unroll
        for (int k = 0; k < 32; ++k) { v[k] -= mean; q += v[k] * v[k]; }
        const float rstd = rsqrtf(wave_sum(q) * (1.0f / DM) + LN_EPS);
#pragma unroll
        for (int j = 0; j < 4; ++j) { const int c0 = 512 * j + 8 * lane; const f32x4 g0 = *(const f32x4*)(g + c0), g1 = *(const f32x4*)(g + c0 + 4), b0 = *(const f32x4*)(b + c0), b1 = *(const f32x4*)(b + c0 + 4); float y[8];
#pragma unroll
            for (int k = 0; k < 4; ++k) { y[k] = v[8 * j + k] * rstd * g0[k] + b0[k]; y[4 + k] = v[8 * j + 4 + k] * rstd * g1[k] + b1[k]; }
            *(f32x4*)(dst + ro + c0) = (f32x4){y[0], y[1], y[2], y[3]}; *(f32x4*)(dst + ro + c0 + 4) = (f32x4){y[4], y[5], y[6], y[7]};
            if (MODE == 0) *(u32x4*)(dstb + ro + c0) = pack8(y); }
    }
}

__device__ __forceinline__ void moe_tables(Frame& F) {
    const int tid = F.wave * 64 + lane_id();
    if (tid == 0) {
        int ub7 = 0, ub8 = 0, roff = 0;
        for (int e = 0; e < NE; ++e) { const int c = (int)__hip_atomic_load(F.ctl + CW_CNT + e, __ATOMIC_RELAXED, __HIP_MEMORY_SCOPE_AGENT); const int nmb = (c + 255) >> 8;
            F.lctl[L_CNT / 4 + e] = c; F.lctl[L_UB7 / 4 + e] = ub7; F.lctl[L_UB8 / 4 + e] = ub8; F.lctl[L_ROFF / 4 + e] = roff; ub7 += nmb * 16; ub8 += nmb * 8; roff += nmb * 256; }
        F.lctl[L_UB7 / 4 + NE] = ub7; F.lctl[L_UB8 / 4 + NE] = ub8; F.lctl[L_ROFF / 4 + NE] = roff;
    }
    __syncthreads();
}

__global__ void __launch_bounds__(NWAVES * 64, 2) fwd(Args args) {
    extern __shared__ __attribute__((aligned(16))) unsigned char lds_raw[];
    Frame F;
    F.lds = (LAS unsigned char*)lds_raw; F.lctl = (volatile LAS int*)(F.lds + LDSCTL_OFF);
    F.wave = __builtin_amdgcn_readfirstlane((int)threadIdx.x >> 6);
    F.G = gridDim.x; { const int bx = blockIdx.x; F.vcu = (F.G % 8 == 0) ? (bx % 8) * (F.G / 8) + bx / 8 : bx; }
    F.a = &args; F.out = args.out; F.ws = args.ws; F.ctl = (gu32*)(args.ws + WS_CTL);
    unsigned char* ws = args.ws;
    for (int u = (int)threadIdx.x; u < (LDS_BYTES - LDSCTL_OFF) / 4; u += NWAVES * 64) ((LAS unsigned*)(F.lds + LDSCTL_OFF))[u] = 0u;
    __syncthreads();
    XcdBarrier bar = xcd_barrier_post((unsigned*)(F.ctl + CW_BAR), (volatile LAS unsigned*)(F.lds + LDSCTL_OFF + L_BARST));
    const int lo = args.ph_lo, hi = args.ph_hi;
#define IN(k) (lo <= (k) && (k) < hi)
#define SEAM(k) do { if (IN(k) && IN((k) + 1)) xcd_barrier(bar); } while (0)
    const int c = (int)blockIdx.x;

    if (IN(0)) { p0_prologue(F); }
    SEAM(0);
    if (IN(1)) {
        { SchedTile S{(const char*)(ws + WS_XB), (const char*)(ws + WS_WIN), DM, DM, NTOK / 256, NIN / 256, F.G, c, 0, (size_t)256 * DM * 2, 0, 1000000};
          EpiProj E{(bf16_t*)(ws + WS_PROJ)}; const int sp = F.vcu % 5;
#pragma unroll 1
          for (int part = 0; part < 2; ++part) { S.i0 = part ? sp : 0; S.n = part ? 4 - sp : sp; gemm_phase(F.lds, F.wave, S, E, DM, DM); if (part == 0) conv_moe(F, F.vcu * 256, F.vcu * 256 + 160); } }
        { SchedTile S{(const char*)(ws + WS_PB), (const char*)(ws + WS_WPLE), PLE, PLE, NTOK / 256, DM / 256, F.G, c, 0, (size_t)256 * PLE * 2, 0, 1000000};
          EpiBf16Scale E{(bf16_t*)(ws + WS_PLEB), DM, nullptr}; gemm_phase(F.lds, F.wave, S, E, PLE, PLE); }
    }
    SEAM(1);
    if (IN(2)) { p2_poolconv(F); }
    SEAM(2);
    if (IN(3)) {
        SchedTile S{(const char*)(ws + WS_POOLED), (const char*)(ws + WS_WPOOL), 1024, 256, NTOK / 256, 4, F.G, c, (size_t)256 * 2, (size_t)256 * 256 * 2, 0, 1000000};
        EpiBf16Scale E{(bf16_t*)(ws + WS_ABUF), 1024, FIN(4)}; gemm_phase(F.lds, F.wave, S, E, 256, 256);
    }
    SEAM(3);
    if (IN(4)) {
        SchedSeg S{(const char*)(ws + WS_ABUF), (const char*)(ws + WS_BCONV), (const char*)(ws + WS_WBRA), (const char*)(ws + WS_WBRB), F.G, c, 0, 2};
        EpiBranch E{(const bf16_t*)(ws + WS_PROJ), (float*)(ws + WS_M1), (bf16_t*)(ws + WS_MB)}; const int sp = F.vcu % 3;
#pragma unroll 1
        for (int part = 0; part < 2; ++part) { S.i0 = part ? sp : 0; S.n = part ? 2 - sp : sp; gemm_phase(F.lds, F.wave, S, E, 1024, 1024); if (part == 0) conv_moe(F, F.vcu * 256 + 160, F.vcu * 256 + 208); }
    }
    SEAM(4);
    if (IN(5)) {
        SchedTile S{(const char*)(ws + WS_MB), (const char*)(ws + WS_WO), DM, DM, NTOK / 256, DM / 256, F.G, c, 0, (size_t)256 * DM * 2, 0, 1000000};
        EpiWo E{FIN(0), (float*)(ws + WS_PRE1)};
        if (F.vcu & 1) conv_moe(F, F.vcu * 256 + 208, F.vcu * 256 + 256);
        gemm_phase(F.lds, F.wave, S, E, DM, DM);
        if (!(F.vcu & 1)) conv_moe(F, F.vcu * 256 + 208, F.vcu * 256 + 256);
    }
    SEAM(5);
    if (IN(6)) { p6_ln1_router(F); }
    SEAM(6);
    if (IN(7) || IN(8)) moe_tables(F);
    if (IN(7)) {
        SchedMoe S{(const char*)(ws + WS_X1B), (const char*)(ws + WS_WGU), (const int*)(ws + WS_LIST), (const LAS int*)(F.lds + LDSCTL_OFF + L_CNT), (const LAS int*)(F.lds + LDSCTL_OFF + L_UB7), (const LAS int*)(F.lds + LDSCTL_OFF + L_ROFF), F.G, F.vcu, 16, true, 0, 1000000};
        EpiGU E{(bf16_t*)(ws + WS_ACT), FIN(14)}; const int sp = F.vcu % 10;
#pragma unroll 1
        for (int part = 0; part < 2; ++part) { S.i0 = part ? sp : 0; S.n = part ? 1000000 : sp; gemm_phase(F.lds, F.wave, S, E, DM, DM); if (part == 0) conv_moe(F, 65536 + F.vcu * 128, 65536 + F.vcu * 128 + 128); }
    }
    SEAM(7);
    if (IN(8)) {
        SchedMoe S{(const char*)(ws + WS_ACT), (const char*)(ws + WS_WDN), (const int*)(ws + WS_LIST), (const LAS int*)(F.lds + LDSCTL_OFF + L_CNT), (const LAS int*)(F.lds + LDSCTL_OFF + L_UB8), (const LAS int*)(F.lds + LDSCTL_OFF + L_ROFF), F.G, F.vcu, 8, false, 0, 1000000};
        EpiDown E{(bf16_t*)(ws + WS_Y), FIN(16), (const int*)(ws + WS_LIST)}; gemm_phase(F.lds, F.wave, S, E, DM, DM);
    }
    SEAM(8);
    if (IN(9)) { row_ln<0>(F); }
    SEAM(9);
    if (IN(10)) {
        SchedTile S{(const char*)(ws + WS_H2B), (const char*)(ws + WS_WPG), DM, DM, NTOK / 256, DM / 256, F.G, c, 0, (size_t)256 * DM * 2, 0, 1000000};
        EpiPg E{(const float*)(ws + WS_H2), (const bf16_t*)(ws + WS_PLEB), FIN(20), F.out}; gemm_phase(F.lds, F.wave, S, E, DM, DM);
    }
    SEAM(10);
    if (IN(11)) { row_ln<1>(F); }
#undef IN
#undef SEAM
}

inline bool launch(void* const* d_in, float* out, void* d_ws, size_t ws_size, hipStream_t stream, int lo, int hi) {
    static int grid = 0;
    if (grid == 0) {
        int dev = 0, cus = 0;
        if (ws_size < WS_END || hipGetDevice(&dev) != hipSuccess || hipDeviceGetAttribute(&cus, hipDeviceAttributeMultiprocessorCount, dev) != hipSuccess) { fprintf(stderr, "fp::launch: setup failed (ws %zu)\n", ws_size); grid = -1; return false; }
        if (hipFuncSetAttribute((const void*)fwd, hipFuncAttributeMaxDynamicSharedMemorySize, LDS_BYTES) != hipSuccess) { fprintf(stderr, "fp::launch: hipFuncSetAttribute failed\n"); grid = -1; return false; }
        if (cus != 256) { fprintf(stderr, "fp::launch: built for 256 CUs, device has %d\n", cus); grid = -1; return false; }
        grid = cus;
    }
    if (grid < 0) return false;
    Args a{};
    for (int i = 0; i < 24; ++i) a.in[i] = (const float*)d_in[i];
    a.out = out; a.ws = (unsigned char*)d_ws; a.ph_lo = lo; a.ph_hi = hi;
    hipLaunchKernelGGL(fwd, dim3(grid), dim3(NWAVES * 64), LDS_BYTES, stream, a);
    return hipPeekAtLastError() == hipSuccess;
}
}
extern "C" void kernel_launch(void* const* d_in, const int* in_sizes, int n_in, void* d_out, int out_size, void* d_ws, size_t ws_size, hipStream_t stream) {
    if (n_in != 24 || out_size != fp::NTOK * fp::DM) { fprintf(stderr, "kernel_launch: unexpected shapes (n_in %d out %d)\n", n_in, out_size); return; }
    if (hipMemsetAsync((char*)d_ws + fp::WS_CTL, 0, fp::CTL_ZERO_BYTES, stream) != hipSuccess) return;
    fp::launch(d_in, (float*)d_out, d_ws, ws_size, stream, 0, 12);
}
```
